# Optimizing an MI355X kernel written in HIP

```python
import jax, jax.numpy as jnp
from jax import lax
import numpy as np

D_MODEL = 1024
BATCH = 8
SEQ = 8192
DEPTH = 4

POOL_WINDOWS = (2, 4, 8, 16)
POOL_GROUPS = len(POOL_WINDOWS)
POOL_GROUP_DIM = D_MODEL // 8
POOL_DIM = POOL_GROUPS * POOL_GROUP_DIM
POOL_WMAX = max(POOL_WINDOWS)
HEAD_DIM = 64
N_Q_HEADS = D_MODEL // 128
N_KV_HEADS = 2
GQA_GROUP = N_Q_HEADS // N_KV_HEADS
ATTN_DIM = N_Q_HEADS * HEAD_DIM
KV_DIM = N_KV_HEADS * HEAD_DIM
WINDOW = 128
BLOCK = 128
ROPE_THETA = 500000.0
ROT_DIM = HEAD_DIM // 4
N_BRANCHES = 2
IN_DIM = POOL_DIM + ATTN_DIM + 2 * KV_DIM + N_BRANCHES * D_MODEL
D_FF = 2816
EPS = 1e-6

kernel_name = "hybrid_pool_swa_macaron"


def rmsnorm(x, g):
    xf = x.astype(jnp.float32)
    y = xf * lax.rsqrt(jnp.mean(xf * xf, axis=-1, keepdims=True) + EPS)
    return (y * g.astype(jnp.float32)).astype(x.dtype)


def swiglu(h, w_gu, w_down):
    g, u = jnp.split(h @ w_gu, 2, axis=-1)
    return (jax.nn.silu(g) * u) @ w_down


def pool_mixer(u, w_grp, scale):
    B, S, _ = u.shape
    uf = u.astype(jnp.float32)
    c = jnp.cumsum(uf, axis=1)
    c_pad = jnp.pad(c, ((0, 0), (POOL_WMAX, 0), (0, 0)))
    t = jnp.arange(S)
    outs = []
    for g, w in enumerate(POOL_WINDOWS):
        lo, hi = g * POOL_GROUP_DIM, (g + 1) * POOL_GROUP_DIM
        win_sum = c[:, :, lo:hi] - c_pad[:, POOL_WMAX - w:POOL_WMAX - w + S, lo:hi]
        count = jnp.minimum(t + 1, w).astype(jnp.float32)[None, :, None]
        outs.append(win_sum / count - uf[:, :, lo:hi])
    d = jnp.stack(outs, axis=2).astype(u.dtype)
    y = jnp.einsum('bsgc,gcd->bsgd', d, w_grp).reshape(B, S, POOL_DIM)
    return y * scale


def partial_rope(x, cos, sin):
    half = ROT_DIM // 2
    x1 = x[..., :half].astype(jnp.float32)
    x2 = x[..., half:ROT_DIM].astype(jnp.float32)
    c = cos[None, :, None, :]
    s = sin[None, :, None, :]
    rot = jnp.concatenate([x1 * c - x2 * s, x2 * c + x1 * s], axis=-1).astype(x.dtype)
    return jnp.concatenate([rot, x[..., ROT_DIM:]], axis=-1)


def swa_sink_attention(q, k, v, sinks):
    B, S = q.shape[0], q.shape[1]
    nb = S // BLOCK
    qb = q.reshape(B, nb, BLOCK, N_KV_HEADS, GQA_GROUP, HEAD_DIM)

    def with_prev(t):
        tb = t.reshape(B, nb, BLOCK, N_KV_HEADS, HEAD_DIM)
        prev = jnp.pad(tb[:, :-1], ((0, 0), (1, 0), (0, 0), (0, 0), (0, 0)))
        return jnp.concatenate([prev, tb], axis=2)

    kb, vb = with_prev(k), with_prev(v)
    s = jnp.einsum('bnqhgd,bnkhd->bnhgqk', qb, kb).astype(jnp.float32) * (HEAD_DIM ** -0.5)
    qi = jnp.arange(BLOCK)[:, None]
    ki = jnp.arange(2 * BLOCK)[None, :]
    diff = qi + BLOCK - ki
    band = (diff >= 0) & (diff < WINDOW)
    valid = (jnp.arange(nb)[:, None, None] > 0) | (ki[None] >= BLOCK)
    mask = band[None] & valid
    s = jnp.where(mask[None, :, None, None], s, -jnp.inf)
    sink = sinks.astype(jnp.float32).reshape(1, 1, N_KV_HEADS, GQA_GROUP, 1, 1)
    m = jnp.maximum(jnp.max(s, axis=-1, keepdims=True), sink)
    p = jnp.exp(s - m)
    denom = jnp.sum(p, axis=-1, keepdims=True) + jnp.exp(sink - m)
    p = (p / denom).astype(v.dtype)
    o = jnp.einsum('bnhgqk,bnkhd->bnqhgd', p, vb)
    return o.reshape(B, S, ATTN_DIM)


def setup_inputs(seed: int = 0) -> dict:
    key = jax.random.key(seed)
    ks = jax.random.split(key, 17)
    f32 = jnp.float32

    def w(k, shape, fan_in):
        return jax.random.normal(k, shape, f32) * (fan_in ** -0.5)

    def gain(k, shape):
        return 1.0 + 0.05 * jax.random.normal(k, shape, f32)

    L = DEPTH
    return {
        "x": jax.random.normal(ks[0], (BATCH, SEQ, D_MODEL), f32),
        "ln_ffn1": gain(ks[1], (L, D_MODEL)),
        "w_ffn1_gu": w(ks[2], (L, D_MODEL, 2 * D_FF), D_MODEL),
        "w_ffn1_down": w(ks[3], (L, D_FF, D_MODEL), D_FF),
        "ln_mix": gain(ks[4], (L, D_MODEL)),
        "w_in": w(ks[5], (L, D_MODEL, IN_DIM), D_MODEL),
        "pool_w": w(ks[6], (L, POOL_GROUPS, POOL_GROUP_DIM, POOL_GROUP_DIM), POOL_GROUP_DIM),
        "pool_scale": 1.0 + 0.1 * jax.random.normal(ks[7], (L, POOL_DIM), f32),
        "w_pool_branch": w(ks[8], (L, POOL_DIM, D_MODEL), POOL_DIM),
        "q_norm": gain(ks[9], (L, HEAD_DIM)),
        "k_norm": gain(ks[10], (L, HEAD_DIM)),
        "sinks": 0.5 * jax.random.normal(ks[11], (L, N_Q_HEADS), f32),
        "w_attn_branch": w(ks[12], (L, ATTN_DIM, D_MODEL), ATTN_DIM),
        "w_out": w(ks[13], (L, D_MODEL, D_MODEL), D_MODEL),
        "ln_ffn2": gain(ks[14], (L, D_MODEL)),
        "w_ffn2_gu": w(ks[15], (L, D_MODEL, 2 * D_FF), D_MODEL),
        "w_ffn2_down": w(ks[16], (L, D_FF, D_MODEL), D_FF),
    }


def reference(x, ln_ffn1, w_ffn1_gu, w_ffn1_down, ln_mix, w_in, pool_w, pool_scale,
              w_pool_branch, q_norm, k_norm, sinks, w_attn_branch, w_out,
              ln_ffn2, w_ffn2_gu, w_ffn2_down):
    B, S, _ = x.shape
    pos = jnp.arange(S, dtype=jnp.float32)
    inv_freq = ROPE_THETA ** (-jnp.arange(0, ROT_DIM, 2, dtype=jnp.float32) / ROT_DIM)
    ang = pos[:, None] * inv_freq[None, :]
    cos, sin = jnp.cos(ang), jnp.sin(ang)
    splits = [POOL_DIM, POOL_DIM + ATTN_DIM, POOL_DIM + ATTN_DIM + KV_DIM,
              POOL_DIM + ATTN_DIM + 2 * KV_DIM]

    for l in range(DEPTH):
        x = x + 0.5 * swiglu(rmsnorm(x, ln_ffn1[l]), w_ffn1_gu[l], w_ffn1_down[l])

        h = rmsnorm(x, ln_mix[l])
        z = h @ w_in[l]
        u_pool, q, k, v, gate_logits = jnp.split(z, splits, axis=-1)

        a = pool_mixer(u_pool, pool_w[l], pool_scale[l]) @ w_pool_branch[l]

        q = rmsnorm(q.reshape(B, S, N_Q_HEADS, HEAD_DIM), q_norm[l])
        k = rmsnorm(k.reshape(B, S, N_KV_HEADS, HEAD_DIM), k_norm[l])
        v = v.reshape(B, S, N_KV_HEADS, HEAD_DIM)
        q = partial_rope(q, cos, sin)
        k = partial_rope(k, cos, sin)
        b = swa_sink_attention(q, k, v, sinks[l]) @ w_attn_branch[l]

        g_pool, g_attn = jnp.split(jax.nn.sigmoid(gate_logits), N_BRANCHES, axis=-1)
        x = x + (g_pool * a + g_attn * b) @ w_out[l]

        x = x + 0.5 * swiglu(rmsnorm(x, ln_ffn2[l]), w_ffn2_gu[l], w_ffn2_down[l])
    return x
```

```cpp
#include <hip/hip_runtime.h>
#include <hip/hip_cooperative_groups.h>
#include <cstdio>
#include <cstdint>
namespace cg = cooperative_groups;

namespace pg8 {
#define PG8_LAS __attribute__((address_space(3)))
typedef unsigned short bf16_t;
typedef short bf16x8 __attribute__((ext_vector_type(8)));
typedef float f32x4 __attribute__((ext_vector_type(4)));
typedef unsigned u32x4 __attribute__((ext_vector_type(4)));
typedef unsigned u32x2 __attribute__((ext_vector_type(2)));
constexpr int BM = 256, BK = 64, HALF = 128, HTB = HALF * BK * 2, STAGE_BYTES = 8 * HTB, NXCD = 8, WGM = 8;

__host__ __device__ __forceinline__ int lds_byte(int r, int c) { const int st = (r >> 4) * 2 + (c >> 5), rr = r & 15, cc = c & 31, ob = rr * 64 + cc * 2; return st * 1024 + (ob ^ (((ob >> 9) & 1) << 5)); }
__host__ __device__ __forceinline__ void stage_rc(int b, int& R, int& C) { const int st = b / 1024, sb = b % 1024, swz = sb ^ (((sb >> 9) & 1) << 5); R = (st >> 1) * 16 + swz / 64; C = (st & 1) * 32 + (swz % 64) / 2; }
__host__ __device__ __forceinline__ int perm32(int rho) { const int n = rho >> 4, i = rho & 15; return 8 * (i >> 2) + 4 * n + (i & 3); }

struct Unit { int pm, pn; };
struct Gemm { const bf16_t* A; const bf16_t* Bt; int M, N, K; };

struct StaticOrder {
    int nM, nN, nwg, G, c;
    __host__ __device__ void init(int M, int N, int G_, int c_) { nM = M / BM; nN = N / BM; nwg = nM * nN; G = G_; c = c_; }
    __host__ __device__ bool next(int i, Unit& u) const {
        const long L = (long)i * G + c; if (L >= nwg) return false;
        int wgid = (int)L; { const int q = nwg / NXCD, r = nwg % NXCD, xcd = wgid % NXCD, off = wgid / NXCD; wgid = (xcd < r ? xcd * (q + 1) : r * (q + 1) + (xcd - r) * q) + off; }
        const int nig = WGM * nN, gid = wgid / nig, fm = gid * WGM, gsz = (nM - fm) < WGM ? (nM - fm) : WGM;
        u.pm = fm + ((wgid % nig) % gsz); u.pn = (wgid % nig) / gsz; return true;
    }
};

__device__ __forceinline__ unsigned cvt_pk_bf16(float lo, float hi) { unsigned r; asm volatile("v_cvt_pk_bf16_f32 %0, %1, %2" : "=v"(r) : "v"(lo), "v"(hi)); return r; }

template <class Epi, bool ALIGN_EPI>
__device__ __forceinline__ void gemm_phase(PG8_LAS unsigned char* lds, const Gemm g, const StaticOrder& S, const Epi& E) {
    int tid = threadIdx.x; asm volatile("" : "+v"(tid));
    const int wid = __builtin_amdgcn_readfirstlane(tid >> 6), lane = tid & 63, wr = wid >> 2, wc = wid & 3, fr = lane & 15, fq = lane >> 4;
    const int K = g.K, nt = K / BK;
    unsigned voffA[2], voffB[2];
#pragma unroll
    for (int i = 0; i < 2; ++i) { int R, C; stage_rc(tid * 16 + i * 8192, R, C); const int Rb = (R & ~31) + perm32(R & 31);
        voffA[i] = (unsigned)(R * K + C) * 2u; voffB[i] = (unsigned)(Rb * K + C) * 2u; }
    const size_t kstep = (size_t)(BK * 2);
    const size_t hstep = (size_t)HALF * K * 2;
    const size_t tstep = 2 * hstep;
    const unsigned ldsw = (unsigned)wid * 1024u;
    const int aoff = lds_byte(wr * 64 + fr, fq * 8), boff = lds_byte(wc * 32 + fr, fq * 8);
#define PG8_SA(b, h) (((b) * 2 + (h)) * HTB)
#define PG8_SB(b, h) ((4 + (b) * 2 + (h)) * HTB)
#define PG8_STAGE(bufoff, gbase, voff) do { _Pragma("unroll") for (int _i = 0; _i < 2; ++_i) \
        __builtin_amdgcn_global_load_lds((const unsigned*)((const char*)(gbase) + (voff)[_i]), (PG8_LAS unsigned*)(lds + (bufoff) + ldsw + _i * 8192), 16, 0, 0); } while (0)
#define PG8_LDA(dst, b, h) do { _Pragma("unroll") for (int m = 0; m < 4; ++m) _Pragma("unroll") for (int k = 0; k < 2; ++k) dst[m][k] = *(const PG8_LAS bf16x8*)(lds + PG8_SA(b, h) + aoff + m * 2048 + k * 1024); } while (0)
#define PG8_LDB(dst, b, h) do { _Pragma("unroll") for (int n = 0; n < 2; ++n) _Pragma("unroll") for (int k = 0; k < 2; ++k) dst[n][k] = *(const PG8_LAS bf16x8*)(lds + PG8_SB(b, h) + boff + n * 2048 + k * 1024); } while (0)
#define PG8_MMA(ai, bj, At, Bt) do { __builtin_amdgcn_s_setprio(1); _Pragma("unroll") for (int m = 0; m < 4; ++m) _Pragma("unroll") for (int n = 0; n < 2; ++n) _Pragma("unroll") for (int k = 0; k < 2; ++k) \
        acc[ai][bj][m][n] = __builtin_amdgcn_mfma_f32_16x16x32_bf16(Bt[n][k], At[m][k], acc[ai][bj][m][n], 0, 0, 0); __builtin_amdgcn_s_setprio(0); } while (0)
#define PG8_WAIT_V(n) asm volatile("s_waitcnt vmcnt(" #n ")" ::: "memory")
#define PG8_WAIT_L(n) asm volatile("s_waitcnt lgkmcnt(" #n ")" ::: "memory")
#define PG8_BAR __builtin_amdgcn_s_barrier()
#define PG8_SCHED __builtin_amdgcn_sched_barrier(0)
    Unit cur, nxt; int ui = 0;
    if (!S.next(0, cur)) return;
    f32x4 acc[2][2][4][2];
#pragma unroll
    for (int a = 0; a < 2; ++a)
#pragma unroll
        for (int b = 0; b < 2; ++b)
#pragma unroll
            for (int m = 0; m < 4; ++m)
#pragma unroll
                for (int n = 0; n < 2; ++n) acc[a][b][m][n] = (f32x4){0.f, 0.f, 0.f, 0.f};
    bf16x8 At[4][2], B0[2][2], B1[2][2];
    typedef float f32x2 __attribute__((ext_vector_type(2)));
    f32x2 rsp = (f32x2){0.f, 0.f};
    PG8_LAS float* rsbuf = (PG8_LAS float*)(lds + STAGE_BYTES + 1024);
    const char* cA = (const char*)g.A + (size_t)cur.pm * tstep; const char* cB = (const char*)g.Bt + (size_t)cur.pn * tstep;
    PG8_STAGE(PG8_SB(0, 0), cB, voffB); PG8_STAGE(PG8_SB(0, 1), cB + hstep, voffB); PG8_STAGE(PG8_SA(0, 0), cA, voffA); PG8_STAGE(PG8_SA(0, 1), cA + hstep, voffA);
    if (wr == 1) PG8_BAR;
    PG8_WAIT_V(2); PG8_BAR;
    PG8_STAGE(PG8_SB(1, 0), cB + kstep, voffB); PG8_STAGE(PG8_SA(1, 0), cA + kstep, voffA); PG8_STAGE(PG8_SB(1, 1), cB + hstep + kstep, voffB);
    PG8_WAIT_V(6); PG8_BAR;
    for (;;) {
        const bool has_next = S.next(ui + 1, nxt);
        const char* nA = has_next ? (const char*)g.A + (size_t)nxt.pm * tstep : cA; const char* nB = has_next ? (const char*)g.Bt + (size_t)nxt.pn * tstep : cB;
        for (int t = 0; t < nt; t += 2) {
            const bool last = (t == nt - 2);
            const char* a1 = cA + (size_t)(t + 1) * kstep;
            const char* a2 = last ? nA : cA + (size_t)(t + 2) * kstep; const char* b2 = last ? nB : cB + (size_t)(t + 2) * kstep;
            const char* a3 = a2 + kstep; const char* b3 = b2 + kstep;
            if constexpr (Epi::NEEDS_RS) { if (last) rsp = *(const f32x2*)(E.ss + ((size_t)(cur.pm * BM + (tid >> 1)) * 4 + (tid & 1) * 2)); }
            PG8_LDB(B0, 0, 0); PG8_LDB(B1, 0, 1); PG8_SCHED; PG8_LDA(At, 0, 0); PG8_STAGE(PG8_SA(1, 1), a1 + hstep, voffA);
            PG8_WAIT_V(8); PG8_WAIT_L(0); PG8_BAR; PG8_MMA(0, 0, At, B0); PG8_MMA(0, 1, At, B1); PG8_BAR; PG8_SCHED;
            PG8_LDA(At, 0, 1); PG8_STAGE(PG8_SB(0, 0), b2, voffB); PG8_STAGE(PG8_SB(0, 1), b2 + hstep, voffB); PG8_STAGE(PG8_SA(0, 0), a2, voffA);
            PG8_WAIT_V(8); PG8_WAIT_L(0); PG8_BAR; PG8_MMA(1, 0, At, B0); PG8_MMA(1, 1, At, B1); PG8_BAR; PG8_SCHED;
            PG8_LDB(B0, 1, 0); PG8_LDB(B1, 1, 1); PG8_SCHED; PG8_LDA(At, 1, 0); PG8_STAGE(PG8_SA(0, 1), a2 + hstep, voffA);
            PG8_WAIT_V(8); PG8_WAIT_L(0); PG8_BAR; PG8_MMA(0, 0, At, B0); PG8_MMA(0, 1, At, B1); PG8_BAR; PG8_SCHED;
            PG8_LDA(At, 1, 1); PG8_STAGE(PG8_SB(1, 0), b3, voffB); PG8_STAGE(PG8_SB(1, 1), b3 + hstep, voffB); PG8_STAGE(PG8_SA(1, 0), a3, voffA);
            PG8_WAIT_V(8); PG8_WAIT_L(0); PG8_BAR; PG8_MMA(1, 0, At, B0); PG8_MMA(1, 1, At, B1); PG8_BAR; PG8_SCHED;
        }
        if constexpr (ALIGN_EPI) { if (wr == 0) PG8_BAR; }
        if constexpr (Epi::NEEDS_RS) {
            float sq = rsp[0] + rsp[1];
            sq += __shfl_xor(sq, 1);
            if ((tid & 1) == 0) rsbuf[tid >> 1] = __builtin_amdgcn_rsqf(sq * (1.f / 1024.f) + 1e-6f);
            PG8_WAIT_L(0); PG8_BAR; asm volatile("" ::: "memory");
        }
        E(acc, cur, wr, wc, fr, fq, rsbuf);
        if (!has_next) break;
#pragma unroll
        for (int a = 0; a < 2; ++a)
#pragma unroll
            for (int b = 0; b < 2; ++b)
#pragma unroll
                for (int m = 0; m < 4; ++m)
#pragma unroll
                    for (int n = 0; n < 2; ++n) acc[a][b][m][n] = (f32x4){0.f, 0.f, 0.f, 0.f};
        cur = nxt; cA = nA; cB = nB; ++ui;
        if constexpr (ALIGN_EPI) { if (wr == 1) PG8_BAR; }
    }
    PG8_WAIT_V(0);
    if constexpr (!ALIGN_EPI) { if (wr == 0) PG8_BAR; }
    PG8_BAR;
#undef PG8_SA
#undef PG8_SB
#undef PG8_STAGE
#undef PG8_LDA
#undef PG8_LDB
#undef PG8_MMA
#undef PG8_WAIT_V
#undef PG8_WAIT_L
#undef PG8_BAR
#undef PG8_SCHED
}
}

using pg8::bf16_t; using pg8::bf16x8; using pg8::f32x4; using pg8::u32x4; using pg8::u32x2; using pg8::Unit; using pg8::cvt_pk_bf16;
typedef float f32x16 __attribute__((ext_vector_type(16)));
#define LAS __attribute__((address_space(3)))

constexpr int DM = 1024, NB = 8, SEQ = 8192, DEPTH = 4, M = NB * SEQ;
constexpr int FF = 2816, NGU = 2 * FF, NIN = 3328, PD = 512, AD = 512, KVD = 128;
constexpr float EPSN = 1e-6f, LOG2E = 1.4426950408889634f;
constexpr float QSCALE = 0.125f * LOG2E;

constexpr size_t MiB = 1u << 20;
constexpr size_t WS_ROPE = 1 * MiB;
constexpr size_t WS_SS = 2 * MiB;
constexpr size_t WS_W = 8 * MiB;
constexpr size_t LW_GU1 = 0, LW_D1 = 11 * MiB, LW_IN = LW_D1 + 11 * MiB / 2, LW_PB = LW_IN + 13 * MiB / 2, LW_AB = LW_PB + 1 * MiB,
                 LW_OUT = LW_AB + 1 * MiB, LW_GU2 = LW_OUT + 2 * MiB, LW_D2 = LW_GU2 + 11 * MiB, LW_BYTES = LW_D2 + 11 * MiB / 2;
static_assert(LW_BYTES == 87 * MiB / 2, "weights per layer");
constexpr size_t WS_XB = 184 * MiB;
constexpr size_t WS_DP = 312 * MiB;
constexpr size_t WS_OA = 376 * MiB;
constexpr size_t WS_BIG = 440 * MiB;
constexpr size_t WS_U = WS_BIG, WS_Q = WS_U + 64 * MiB, WS_K = WS_Q + 64 * MiB, WS_VT = WS_K + 16 * MiB, WS_G = WS_VT + 16 * MiB, WS_END = WS_G + 256 * MiB;
static_assert(WS_W + 4 * LW_BYTES <= WS_XB && WS_BIG + (size_t)M * FF * 2 <= WS_END && WS_END <= 1024 * MiB, "d_ws map");

__device__ __forceinline__ float bf_lo(unsigned w) { return __uint_as_float(w << 16); }
__device__ __forceinline__ float bf_hi(unsigned w) { return __uint_as_float(w & 0xffff0000u); }
__device__ __forceinline__ u32x4 pack8(const f32x4 a, const f32x4 b) { u32x4 w; w.x = cvt_pk_bf16(a[0], a[1]); w.y = cvt_pk_bf16(a[2], a[3]); w.z = cvt_pk_bf16(b[0], b[1]); w.w = cvt_pk_bf16(b[2], b[3]); return w; }

struct EpiGU {
    static constexpr bool NEEDS_RS = true;
    bf16_t* H; const float* ss;
    __device__ __forceinline__ void operator()(const f32x4 (&acc)[2][2][4][2], const Unit& u, int wr, int wc, int fr, int fq, const PG8_LAS float* rsbuf) const {
        const int row0 = u.pm * 256 + wr * 64 + fr, col0 = u.pn * 128 + wc * 32 + 8 * fq;
#pragma unroll
        for (int ai = 0; ai < 2; ++ai)
#pragma unroll
            for (int m = 0; m < 4; ++m) {
                const int row = row0 + ai * 128 + m * 16;
                const float rs = rsbuf[ai * 128 + wr * 64 + m * 16 + fr];
                const float c1 = -LOG2E * rs, rs2 = rs * rs;
                f32x4 h[2];
#pragma unroll
                for (int n = 0; n < 2; ++n) { const f32x4 ag = acc[ai][0][m][n], au = acc[ai][1][m][n];
                    const f32x4 t = ag * c1; f32x4 e;
#pragma unroll
                    for (int k = 0; k < 4; ++k) e[k] = __builtin_amdgcn_exp2f(t[k]);
                    const f32x4 d = e + 1.0f; f32x4 r;
#pragma unroll
                    for (int k = 0; k < 4; ++k) r[k] = __builtin_amdgcn_rcpf(d[k]);
                    h[n] = ((ag * au) * rs2) * r; }
                *(u32x4*)(H + (size_t)row * FF + col0) = pack8(h[0], h[1]);
            }
    }
};

struct EpiResid {
    static constexpr bool NEEDS_RS = false;
    const float* base; float* out; bf16_t* xb; float* ss_out; float scale;
    __device__ __forceinline__ void operator()(const f32x4 (&acc)[2][2][4][2], const Unit& u, int wr, int wc, int fr, int fq, const PG8_LAS float* rsbuf) const {
        const int row0 = u.pm * 256 + wr * 64 + fr, col0 = u.pn * 256 + wc * 32 + 8 * fq;
        PG8_LAS float* sqbuf = (PG8_LAS float*)(rsbuf + 256);
#pragma unroll
        for (int ai = 0; ai < 2; ++ai)
#pragma unroll
            for (int m = 0; m < 4; ++m) {
                const int row = row0 + ai * 128 + m * 16; float sq = 0.f;
#pragma unroll
                for (int bj = 0; bj < 2; ++bj) { const size_t off = (size_t)row * DM + col0 + bj * 128;
                    const f32x4 v0 = *(const f32x4*)(base + off) + acc[ai][bj][m][0] * scale, v1 = *(const f32x4*)(base + off + 4) + acc[ai][bj][m][1] * scale;
                    *(f32x4*)(out + off) = v0; *(f32x4*)(out + off + 4) = v1;
                    if (xb) *(u32x4*)(xb + off) = pack8(v0, v1);
                    sq += (v0[0] * v0[0] + v0[1] * v0[1]) + (v0[2] * v0[2] + v0[3] * v0[3]) + (v1[0] * v1[0] + v1[1] * v1[1]) + (v1[2] * v1[2] + v1[3] * v1[3]); }
                if (ss_out) { sq += __shfl_xor(sq, 16); sq += __shfl_xor(sq, 32);
                    if (fq == 0) sqbuf[(ai * 128 + wr * 64 + m * 16 + fr) * 4 + wc] = sq; }
                if (m == 3) asm volatile("" ::: "memory");
            }
        if (ss_out) {
            asm volatile("s_waitcnt lgkmcnt(0)" ::: "memory"); __builtin_amdgcn_s_barrier(); asm volatile("" ::: "memory");
            const int t = (wr * 4 + wc) * 64 + fq * 16 + fr;
            if (t < 256) { const f32x4 p = *(const PG8_LAS f32x4*)(sqbuf + t * 4); ss_out[(size_t)(u.pm * 256 + t) * 4 + u.pn] = (p[0] + p[1]) + (p[2] + p[3]); }
        }
    }
};

struct EpiWin {
    static constexpr bool NEEDS_RS = true;
    const float* ss; bf16_t *U, *Q, *Kb, *VT, *G; const float *qn, *kn, *rope;
    __device__ __forceinline__ void operator()(const f32x4 (&acc)[2][2][4][2], const Unit& u, int wr, int wc, int fr, int fq, const PG8_LAS float* rsbuf) const {
        const int row0 = u.pm * 256 + wr * 64 + fr, pn = u.pn;
        if (pn < 2 || pn >= 5) {
            const bool sig = pn >= 5;
            bf16_t* dst = sig ? G + (pn - 5) * 256 : U + pn * 256; const int ld = sig ? 2048 : 512;
            dst += wc * 32 + 8 * fq;
#pragma unroll
            for (int ai = 0; ai < 2; ++ai)
#pragma unroll
                for (int m = 0; m < 4; ++m) {
                    const int row = row0 + ai * 128 + m * 16;
                    const float rs = rsbuf[ai * 128 + wr * 64 + m * 16 + fr];
#pragma unroll
                    for (int bj = 0; bj < 2; ++bj) { f32x4 v0 = acc[ai][bj][m][0] * rs, v1 = acc[ai][bj][m][1] * rs;
                        if (sig) {
#pragma unroll
                            for (int e = 0; e < 4; ++e) { v0[e] = __builtin_amdgcn_rcpf(1.f + __builtin_amdgcn_exp2f(-LOG2E * v0[e])); v1[e] = __builtin_amdgcn_rcpf(1.f + __builtin_amdgcn_exp2f(-LOG2E * v1[e])); } }
                        *(u32x4*)(dst + (size_t)row * ld + bj * 128) = pack8(v0, v1); }
                }
        } else if (pn < 4 || wc < 2) {
            const bool isq = pn < 4;
            const float* gain = isq ? qn : kn;
            const f32x4 g00 = *(const f32x4*)(gain + (fq < 2 ? 4 * fq : 8 * fq)), g01 = *(const f32x4*)(gain + (fq < 2 ? 4 * fq + 8 : 8 * fq + 4));
            const f32x4 g10 = *(const f32x4*)(gain + 32 + 8 * fq), g11 = *(const f32x4*)(gain + 36 + 8 * fq);
            const float osc = isq ? QSCALE : 1.f;
            bf16_t* dst = isq ? Q + (4 * (pn - 2) + wc) * 64 : Kb + wc * 64; const int ld = isq ? AD : KVD;
            dst += 8 * fq;
#pragma unroll
            for (int ai = 0; ai < 2; ++ai)
#pragma unroll
                for (int m = 0; m < 4; ++m) {
                    const int row = row0 + ai * 128 + m * 16;
                    const float rs = rsbuf[ai * 128 + wr * 64 + m * 16 + fr];
                    f32x4 a = acc[ai][0][m][0] * rs, b = acc[ai][0][m][1] * rs, c = acc[ai][1][m][0] * rs, d = acc[ai][1][m][1] * rs;
                    float sq = (a[0] * a[0] + a[1] * a[1]) + (a[2] * a[2] + a[3] * a[3]) + (b[0] * b[0] + b[1] * b[1]) + (b[2] * b[2] + b[3] * b[3])
                             + (c[0] * c[0] + c[1] * c[1]) + (c[2] * c[2] + c[3] * c[3]) + (d[0] * d[0] + d[1] * d[1]) + (d[2] * d[2] + d[3] * d[3]);
                    sq += __shfl_xor(sq, 16); sq += __shfl_xor(sq, 32);
                    const float rq = __builtin_amdgcn_rsqf(sq * (1.f / 64.f) + EPSN);
                    a = a * rq * g00; b = b * rq * g01; c = c * (rq * osc) * g10; d = d * (rq * osc) * g11;
                    const int t = row & (SEQ - 1);
                    const f32x4 cs = *(const f32x4*)(rope + t * 16 + 4 * (fq & 1)), sn = *(const f32x4*)(rope + t * 16 + 8 + 4 * (fq & 1));
                    const f32x4 ra = a * cs - b * sn, rb = b * cs + a * sn;
                    if (fq < 2) { a = ra; b = rb; }
                    a = a * osc; b = b * osc;
                    *(u32x4*)(dst + (size_t)row * ld) = pack8(a, b);
                    *(u32x4*)(dst + (size_t)row * ld + 32) = pack8(c, d);
                    if (m & 1) asm volatile("" ::: "memory");
                }
        } else {
            const int hv = wc - 2;
#pragma unroll
            for (int ai = 0; ai < 2; ++ai)
#pragma unroll
                for (int m = 0; m < 4; ++m) {
                    const int row = row0 + ai * 128 + m * 16;
                    const float rs = rsbuf[ai * 128 + wr * 64 + m * 16 + fr];
                    bf16_t* vb = VT + ((size_t)((row >> 13) * 2 + hv) * 64 + 8 * fq) * SEQ + (row & (SEQ - 1));
#pragma unroll
                    for (int bj = 0; bj < 2; ++bj)
#pragma unroll
                        for (int n = 0; n < 2; ++n) { const f32x4 v = acc[ai][bj][m][n] * rs;
                            const unsigned w0 = cvt_pk_bf16(v[0], v[1]), w1 = cvt_pk_bf16(v[2], v[3]);
                            bf16_t* p = vb + (size_t)(32 * bj + 4 * n) * SEQ;
                            p[0] = (bf16_t)(w0 & 0xffffu); p[SEQ] = (bf16_t)(w0 >> 16); p[2 * SEQ] = (bf16_t)(w1 & 0xffffu); p[3 * SEQ] = (bf16_t)(w1 >> 16); }
                }
        }
    }
};

template <bool SECOND> struct EpiBranch {
    static constexpr bool NEEDS_RS = false;
    bf16_t* Mb; const bf16_t* G;
    __device__ __forceinline__ void operator()(const f32x4 (&acc)[2][2][4][2], const Unit& u, int wr, int wc, int fr, int fq, const PG8_LAS float* rsbuf) const {
        const int row0 = u.pm * 256 + wr * 64 + fr, col0 = u.pn * 256 + wc * 32 + 8 * fq;
#pragma unroll
        for (int ai = 0; ai < 2; ++ai)
#pragma unroll
            for (int m = 0; m < 4; ++m) {
                const int row = row0 + ai * 128 + m * 16;
#pragma unroll
                for (int bj = 0; bj < 2; ++bj) { const int col = col0 + bj * 128;
                    const u32x4 gw = *(const u32x4*)(G + (size_t)row * 2048 + (SECOND ? 1024 : 0) + col);
                    f32x4 v0 = acc[ai][bj][m][0] * (f32x4){bf_lo(gw.x), bf_hi(gw.x), bf_lo(gw.y), bf_hi(gw.y)};
                    f32x4 v1 = acc[ai][bj][m][1] * (f32x4){bf_lo(gw.z), bf_hi(gw.z), bf_lo(gw.w), bf_hi(gw.w)};
                    bf16_t* mp = Mb + (size_t)row * DM + col;
                    if (SECOND) { const u32x4 pw = *(const u32x4*)mp;
                        v0 = v0 + (f32x4){bf_lo(pw.x), bf_hi(pw.x), bf_lo(pw.y), bf_hi(pw.y)}; v1 = v1 + (f32x4){bf_lo(pw.z), bf_hi(pw.z), bf_lo(pw.w), bf_hi(pw.w)}; }
                    *(u32x4*)mp = pack8(v0, v1); }
            }
    }
};

__device__ __forceinline__ int sigma_inv4(int d4) { return d4 < 16 ? 8 * ((d4 >> 2) & 1) + 4 * (d4 >> 3) : d4; }
template <int MODE> __device__ __forceinline__ int src_group(int n0, bool& perm) {
    perm = false;
    if (MODE == 0) return n0;
    if (MODE == 1) { const int tile = n0 >> 8, loc = n0 & 255; return loc < 128 ? tile * 128 + loc : FF + tile * 128 + (loc - 128); }
    if (n0 < 512 || n0 >= 1280) return n0;
    const int pn = n0 >> 8, loc = n0 & 255, bj = loc >> 7, wc = (loc & 127) >> 5;
    if (pn < 4) { perm = (bj == 0); return 512 + (4 * (pn - 2) + wc) * 64 + 32 * bj; }
    if (wc < 2) { perm = (bj == 0); return 1024 + 64 * wc + 32 * bj; }
    return 1152 + 64 * (wc - 2) + 32 * bj;
}
struct TItem { const float* W; const float* gain; bf16_t* WT; int K, N, mode, r; };
__device__ __forceinline__ int src_group_rt(int mode, int n0, bool& perm) { if (mode == 1) return src_group<1>(n0, perm); if (mode == 2) return src_group<2>(n0, perm); return src_group<0>(n0, perm); }
__device__ __forceinline__ void titem_load(const TItem& t, int lane, f32x4 (&v)[8], int& jd) {
    const int nblk = t.N / 32, kb = t.r / nblk, nb = t.r % nblk, k0 = 64 * kb, n0 = 32 * nb;
    bool perm; const int src = src_group_rt(t.mode, n0, perm);
    const int c4 = 4 * (lane & 7); jd = perm ? sigma_inv4(c4) : c4;
#pragma unroll
    for (int i = 0; i < 8; ++i) { const int kk = 8 * i + (lane >> 3);
        v[i] = *(const f32x4*)(t.W + (size_t)(k0 + kk) * t.N + src + c4);
        if (t.gain) v[i] = v[i] * t.gain[k0 + kk]; }
}
__device__ __forceinline__ void titem_store(const TItem& t, LAS float* scr, int lane, const f32x4 (&v)[8], int jd) {
    const int nblk = t.N / 32, kb = t.r / nblk, nb = t.r % nblk, k0 = 64 * kb, n0 = 32 * nb;
#pragma unroll
    for (int i = 0; i < 8; ++i) { const int kk = 8 * i + (lane >> 3); LAS float* s = scr + kk * 33 + jd; s[0] = v[i][0]; s[1] = v[i][1]; s[2] = v[i][2]; s[3] = v[i][3]; }
    asm volatile("s_waitcnt lgkmcnt(0)" ::: "memory");
    const int c = lane & 7;
#pragma unroll
    for (int j = 0; j < 4; ++j) { const int n = (lane >> 3) + 8 * j; const LAS float* s = scr + (8 * c) * 33 + n;
        u32x4 o; o.x = cvt_pk_bf16(s[0 * 33], s[1 * 33]); o.y = cvt_pk_bf16(s[2 * 33], s[3 * 33]); o.z = cvt_pk_bf16(s[4 * 33], s[5 * 33]); o.w = cvt_pk_bf16(s[6 * 33], s[7 * 33]);
        *(u32x4*)(t.WT + (size_t)(n0 + n) * t.K + k0 + 8 * c) = o; }
    asm volatile("s_waitcnt lgkmcnt(0)" ::: "memory");
}

struct Args {
    const float *x, *ln1, *wgu1, *wd1, *lnm, *win, *poolw, *pscale, *wpb, *qn, *kn, *sinks, *wab, *wout, *ln2, *wgu2, *wd2;
    float* out; unsigned char* ws;
};

__device__ __forceinline__ float wave_sum(float v) {
#pragma unroll
    for (int o = 1; o < 64; o <<= 1) v += __shfl_xor(v, o);
    return v;
}

__device__ __forceinline__ void prologue(const Args& a, LAS unsigned char* lds, int gw, int NGW, int lane, int wave) {
    LAS float* scr = (LAS float*)(lds + wave * 16384);
    unsigned char* ws = a.ws;
    constexpr int I_GU = (DM / 64) * (NGU / 32), I_D = (FF / 64) * (DM / 32), I_IN = (DM / 64) * (NIN / 32), I_AB = (AD / 64) * (DM / 32), I_OUT = (DM / 64) * (DM / 32);
    constexpr int I_LAYER = 2 * I_GU + 2 * I_D + I_IN + I_AB + I_OUT;
    auto resolve = [&](int it) {
        TItem t; const int l = it / I_LAYER; int r = it % I_LAYER;
        unsigned char* wl = ws + WS_W + (size_t)l * LW_BYTES;
        if (r < I_GU) { t = TItem{a.wgu1 + (size_t)l * DM * NGU, a.ln1 + l * DM, (bf16_t*)(wl + LW_GU1), DM, NGU, 1, r}; return t; } r -= I_GU;
        if (r < I_GU) { t = TItem{a.wgu2 + (size_t)l * DM * NGU, a.ln2 + l * DM, (bf16_t*)(wl + LW_GU2), DM, NGU, 1, r}; return t; } r -= I_GU;
        if (r < I_D) { t = TItem{a.wd1 + (size_t)l * FF * DM, nullptr, (bf16_t*)(wl + LW_D1), FF, DM, 0, r}; return t; } r -= I_D;
        if (r < I_D) { t = TItem{a.wd2 + (size_t)l * FF * DM, nullptr, (bf16_t*)(wl + LW_D2), FF, DM, 0, r}; return t; } r -= I_D;
        if (r < I_IN) { t = TItem{a.win + (size_t)l * DM * NIN, a.lnm + l * DM, (bf16_t*)(wl + LW_IN), DM, NIN, 2, r}; return t; } r -= I_IN;
        if (r < I_AB) { t = TItem{a.wab + (size_t)l * AD * DM, nullptr, (bf16_t*)(wl + LW_AB), AD, DM, 0, r}; return t; } r -= I_AB;
        t = TItem{a.wout + (size_t)l * DM * DM, nullptr, (bf16_t*)(wl + LW_OUT), DM, DM, 0, r}; return t;
    };
    for (int it = gw; it < DEPTH * I_LAYER; it += 2 * NGW) {
        const bool hasB = it + NGW < DEPTH * I_LAYER;
        const TItem A = resolve(it), B = resolve(hasB ? it + NGW : it);
        f32x4 va[8], vb[8]; int ja, jb;
        titem_load(A, lane, va, ja); titem_load(B, lane, vb, jb);
        titem_store(A, scr, lane, va, ja);
        if (hasB) titem_store(B, scr, lane, vb, jb);
    }
    for (int it = gw; it < DEPTH * 1024; it += NGW) {
        const int l = it >> 10, r = it & 1023, nb = r & 15, co = (r >> 4) & 15, g = r >> 8;
        const int n = nb * 64 + lane, c0 = co * 8;
        const float* pw = a.poolw + ((size_t)(l * 4 + g) * 128 + c0) * 128;
        const float* sc = a.pscale + l * PD + g * 128;
        const float* wp = a.wpb + ((size_t)l * PD + g * 128) * DM + n;
        float s[8] = {0.f, 0.f, 0.f, 0.f, 0.f, 0.f, 0.f, 0.f};
        for (int d = 0; d < 128; ++d) { const float w = sc[d] * wp[(size_t)d * DM];
#pragma unroll
            for (int i = 0; i < 8; ++i) s[i] += pw[i * 128 + d] * w; }
        u32x4 o; o.x = cvt_pk_bf16(s[0], s[1]); o.y = cvt_pk_bf16(s[2], s[3]); o.z = cvt_pk_bf16(s[4], s[5]); o.w = cvt_pk_bf16(s[6], s[7]);
        *(u32x4*)((bf16_t*)(ws + WS_W + (size_t)l * LW_BYTES + LW_PB) + (size_t)n * PD + g * 128 + c0) = o;
    }
    float* rope = (float*)(ws + WS_ROPE);
    for (int i = gw * 64 + lane; i < SEQ * 8; i += NGW * 64) { const int t = i >> 3, k = i & 7;
        const float inv = powf(500000.0f, -(float)(2 * k) / 16.0f); const float ang = (float)t * inv; float sn, cs; sincosf(ang, &sn, &cs);
        rope[t * 16 + k] = cs; rope[t * 16 + 8 + k] = sn; }
    float* ss = (float*)(ws + WS_SS);
    bf16_t* XB = (bf16_t*)(ws + WS_XB);
    for (int row0 = gw; row0 < M; row0 += 4 * NGW) {
        f32x4 v[4][4];
#pragma unroll
        for (int q = 0; q < 4; ++q) { const int row = row0 + q * NGW; const float* xr = a.x + (size_t)(row < M ? row : row0) * DM + 8 * lane;
#pragma unroll
            for (int j = 0; j < 2; ++j) { v[q][2 * j] = *(const f32x4*)(xr + 512 * j); v[q][2 * j + 1] = *(const f32x4*)(xr + 512 * j + 4); } }
#pragma unroll
        for (int q = 0; q < 4; ++q) { const int row = row0 + q * NGW; if (row >= M) break; float sq = 0.f;
#pragma unroll
            for (int j = 0; j < 2; ++j) { const f32x4 v0 = v[q][2 * j], v1 = v[q][2 * j + 1];
                sq += (v0[0] * v0[0] + v0[1] * v0[1]) + (v0[2] * v0[2] + v0[3] * v0[3]) + (v1[0] * v1[0] + v1[1] * v1[1]) + (v1[2] * v1[2] + v1[3] * v1[3]);
                *(u32x4*)(XB + (size_t)row * DM + 8 * lane + 512 * j) = pack8(v0, v1); }
            sq = wave_sum(sq);
            if (lane < 4) ss[(size_t)row * 4 + lane] = lane == 0 ? sq : 0.f; }
    }
}

__device__ __forceinline__ void unpack8(const u32x4 w, float (&f)[8]) { f[0] = bf_lo(w.x); f[1] = bf_hi(w.x); f[2] = bf_lo(w.y); f[3] = bf_hi(w.y); f[4] = bf_lo(w.z); f[5] = bf_hi(w.z); f[6] = bf_lo(w.w); f[7] = bf_hi(w.w); }

template <int W> __device__ __forceinline__ void pool_item(const bf16_t* __restrict__ U, bf16_t* __restrict__ Dp, int row0, int ch) {
    const int tl0 = row0 & (SEQ - 1);
    u32x4 r[W + 7];
#pragma unroll
    for (int j = 0; j < W + 7; ++j) { const int dt = j - (W - 1);
        r[j] = (tl0 + dt >= 0) ? *(const u32x4*)(U + (size_t)(row0 + dt) * PD + ch) : (u32x4){0u, 0u, 0u, 0u}; }
    float s[8] = {0.f, 0.f, 0.f, 0.f, 0.f, 0.f, 0.f, 0.f};
#pragma unroll
    for (int j = 0; j < W - 1; ++j) { float f[8]; unpack8(r[j], f);
#pragma unroll
        for (int e = 0; e < 8; ++e) s[e] += f[e]; }
#pragma unroll
    for (int i = 0; i < 8; ++i) {
        float cur[8]; unpack8(r[W - 1 + i], cur);
#pragma unroll
        for (int e = 0; e < 8; ++e) s[e] += cur[e];
        const int cnt = (tl0 + i + 1 < W) ? (tl0 + i + 1) : W;
        const float inv = 1.0f / (float)cnt;
        f32x4 o0, o1;
#pragma unroll
        for (int e = 0; e < 4; ++e) { o0[e] = s[e] * inv - cur[e]; o1[e] = s[4 + e] * inv - cur[4 + e]; }
        *(u32x4*)(Dp + (size_t)(row0 + i) * PD + ch) = pack8(o0, o1);
        float old[8]; unpack8(r[i], old);
#pragma unroll
        for (int e = 0; e < 8; ++e) s[e] -= old[e];
    }
}

__device__ __forceinline__ void attn_item(const bf16_t* __restrict__ Q, const bf16_t* __restrict__ Kb, const bf16_t* __restrict__ VT, bf16_t* __restrict__ Oa, float sink2, int b, int h, int q0, int lane) {
    const int i = lane & 31, hi = lane >> 5, hk = h >> 2;
    const size_t rowbase = (size_t)b * SEQ;
    const int pi = (i & 19) | ((i & 4) << 1) | ((i & 8) >> 1);
    const int jmin = q0 >= 128 ? 0 : 4 - (q0 >> 5);
    bf16x8 qf[4];
    const bf16_t* qp = Q + (rowbase + q0 + i) * AD + h * 64 + 8 * hi;
#pragma unroll
    for (int s = 0; s < 4; ++s) qf[s] = *(const bf16x8*)(qp + 16 * s);
    bf16x8 kf[5][4];
#pragma unroll
    for (int j = 0; j < 5; ++j) { const int jj = j < jmin ? jmin : j;
        const bf16_t* kp = Kb + (rowbase + q0 - 128 + 32 * jj + pi) * KVD + hk * 64 + 8 * hi;
#pragma unroll
        for (int s = 0; s < 4; ++s) kf[j][s] = *(const bf16x8*)(kp + 16 * s); }
    f32x16 sc[5];
#pragma unroll
    for (int j = 0; j < 5; ++j) { sc[j] = (f32x16){};
#pragma unroll
        for (int s = 0; s < 4; ++s) sc[j] = __builtin_amdgcn_mfma_f32_32x32x16_bf16(kf[j][s], qf[s], sc[j], 0, 0, 0); }
    asm volatile("" ::: "memory");
    bf16x8 vf[5][2][2];
    const bf16_t* vp = VT + ((size_t)(b * 2 + hk) * 64 + i) * SEQ + 8 * hi;
#pragma unroll
    for (int j = 0; j < 5; ++j) { const int jj = j < jmin ? jmin : j; const int kb = q0 - 128 + 32 * jj;
#pragma unroll
        for (int ks = 0; ks < 2; ++ks)
#pragma unroll
            for (int dt = 0; dt < 2; ++dt) vf[j][ks][dt] = *(const bf16x8*)(vp + (size_t)(32 * dt) * SEQ + kb + 16 * ks); }
    const float NEG = -INFINITY;
    float mx = sink2;
#pragma unroll
    for (int j = 0; j < 5; ++j) {
#pragma unroll
        for (int r = 0; r < 16; ++r) { const int kk = 8 * hi + (r & 7) + 16 * (r >> 3);
            bool ok = j >= jmin;
            if (j == 0) ok = ok && (kk >= i + 1);
            if (j == 4) ok = ok && (kk <= i);
            sc[j][r] = ok ? sc[j][r] : NEG;
            mx = fmaxf(mx, sc[j][r]); } }
    mx = fmaxf(mx, __shfl_xor(mx, 32));
    float l = 0.f;
    f32x16 o[2]; o[0] = (f32x16){}; o[1] = (f32x16){};
#pragma unroll
    for (int j = 0; j < 5; ++j) {
#pragma unroll
        for (int r = 0; r < 16; ++r) { sc[j][r] = __builtin_amdgcn_exp2f(sc[j][r] - mx); l += sc[j][r]; }
        u32x4 pw[2];
        pw[0] = (u32x4){cvt_pk_bf16(sc[j][0], sc[j][1]), cvt_pk_bf16(sc[j][2], sc[j][3]), cvt_pk_bf16(sc[j][4], sc[j][5]), cvt_pk_bf16(sc[j][6], sc[j][7])};
        pw[1] = (u32x4){cvt_pk_bf16(sc[j][8], sc[j][9]), cvt_pk_bf16(sc[j][10], sc[j][11]), cvt_pk_bf16(sc[j][12], sc[j][13]), cvt_pk_bf16(sc[j][14], sc[j][15])};
#pragma unroll
        for (int ks = 0; ks < 2; ++ks)
#pragma unroll
            for (int dt = 0; dt < 2; ++dt) o[dt] = __builtin_amdgcn_mfma_f32_32x32x16_bf16(vf[j][ks][dt], __builtin_bit_cast(bf16x8, pw[ks]), o[dt], 0, 0, 0);
        __builtin_amdgcn_sched_barrier(0);
    }
    l += __shfl_xor(l, 32);
    l += __builtin_amdgcn_exp2f(sink2 - mx);
    const float rl = 1.0f / l;
    bf16_t* op = Oa + (rowbase + q0 + i) * AD + h * 64 + 4 * hi;
#pragma unroll
    for (int dt = 0; dt < 2; ++dt)
#pragma unroll
        for (int rq = 0; rq < 4; ++rq) { u32x2 w; w.x = cvt_pk_bf16(o[dt][4 * rq] * rl, o[dt][4 * rq + 1] * rl); w.y = cvt_pk_bf16(o[dt][4 * rq + 2] * rl, o[dt][4 * rq + 3] * rl);
            *(u32x2*)(op + 32 * dt + 8 * rq) = w; }
}

__device__ __forceinline__ void mixer_phase(const Args& a, int l, int gw, int NGW, int lane) {
    asm volatile("" : "+v"(lane));
    unsigned char* ws = a.ws;
    const bf16_t* U = (const bf16_t*)(ws + WS_U); bf16_t* Dp = (bf16_t*)(ws + WS_DP);
    for (int it = gw; it < (M / 32) * 4; it += NGW) {
        const int g = it & 3, chunk = it >> 2;
        const int row0 = chunk * 32 + (lane >> 4) * 8, ch = g * 128 + (lane & 15) * 8;
        if (g == 0) pool_item<2>(U, Dp, row0, ch); else if (g == 1) pool_item<4>(U, Dp, row0, ch); else if (g == 2) pool_item<8>(U, Dp, row0, ch); else pool_item<16>(U, Dp, row0, ch);
    }
    const bf16_t* Q = (const bf16_t*)(ws + WS_Q); const bf16_t* Kb = (const bf16_t*)(ws + WS_K); const bf16_t* VT = (const bf16_t*)(ws + WS_VT); bf16_t* Oa = (bf16_t*)(ws + WS_OA);
    for (int it = gw; it < NB * 8 * (SEQ / 32); it += NGW) {
        const int g = it & 3, qb = (it >> 2) & 255, hk = (it >> 10) & 1, b = it >> 11, h = hk * 4 + g;
        const float sink2 = a.sinks[l * 8 + h] * LOG2E;
        attn_item(Q, Kb, VT, Oa, sink2, b, h, qb * 32, lane);
    }
}


#define XB_TMO      128
#define XB_XCNT(j)  (256  + 64 * (j))
#define XB_XSUB(j)  (1280 + 64 * (j))
#define XB_XGEN(j)  (2304 + 64 * (j))
#define XB_TOP      3328
#define XB_TOPGEN   3392
#define XCD_BAR_WORDS 3456
#define XB_SPIN_CAP (1u << 22)
__device__ __forceinline__ unsigned xb_ld(unsigned* p)              { return __hip_atomic_load(p, __ATOMIC_RELAXED, __HIP_MEMORY_SCOPE_AGENT); }
__device__ __forceinline__ unsigned xb_add(unsigned* p, unsigned v) { return __hip_atomic_fetch_add(p, v, __ATOMIC_RELAXED, __HIP_MEMORY_SCOPE_AGENT); }
__device__ __forceinline__ unsigned xb_xcc_id() { return (unsigned)__builtin_amdgcn_s_getreg((3 << 11) | 20) & 0xFu; }
#define XB_SPIN(cond, bar) do { unsigned _sp = 0; while (cond) { __builtin_amdgcn_s_sleep(1); \
    if ((++_sp & 255u) == 0u) { if (xb_ld(&(bar)[XB_TMO])) break; if (_sp > XB_SPIN_CAP) { atomicAdd(&(bar)[XB_TMO], 1u); break; } } } } while (0)
__device__ __forceinline__ void xcd_barrier_post(unsigned* bar) { if (threadIdx.x == 0) (void)xb_add(&bar[XB_XCNT(xb_xcc_id())], 1u); }
__device__ __forceinline__ void xcd_barrier_complete(unsigned* bar, unsigned x, unsigned& nloc, unsigned& nx) {
    const unsigned G = gridDim.x * gridDim.y * gridDim.z;
    unsigned sum, cnt, mine, sp = 0u;
    for (;;) {
        sum = 0u; cnt = 0u; mine = 0u;
#pragma unroll
        for (unsigned j = 0; j < 16; ++j) { const unsigned c = xb_ld(&bar[XB_XCNT(j)]); sum += c; cnt += (c > 0u) ? 1u : 0u; mine = (j == x) ? c : mine; }
        if (sum == G) break;
        __builtin_amdgcn_s_sleep(1);
        if ((++sp & 255u) == 0u) { if (xb_ld(&bar[XB_TMO])) break; if (sp > XB_SPIN_CAP) { atomicAdd(&bar[XB_TMO], 1u); break; } }
    }
    nloc = mine > 0u ? mine : 1u; nx = cnt > 0u ? cnt : 1u;
}
__device__ __forceinline__ void xcd_barrier(unsigned* bar_in, volatile LAS unsigned* st) {
    asm volatile("s_waitcnt vmcnt(0)" ::: "memory");
    __syncthreads();
    int t0 = threadIdx.x; asm volatile("" : "+v"(t0));
    if (t0 == 0) {
        unsigned* bar = bar_in; asm volatile("" : "+s"(bar));
        const unsigned bx = xb_xcc_id();
        __builtin_amdgcn_s_waitcnt(0);
        unsigned nloc = st[0], nx = st[1];
        if (nloc == 0u) { xcd_barrier_complete(bar, bx, nloc, nx); st[0] = nloc; st[1] = nx; }
        const unsigned old = xb_add(&bar[XB_XSUB(bx)], 1u);
        const unsigned gen = old / nloc;
        if (old + 1u == (gen + 1u) * nloc) {
            __builtin_amdgcn_fence(__ATOMIC_RELEASE, "agent");
            asm volatile("s_waitcnt vmcnt(0)" ::: "memory");
            const unsigned og = xb_add(&bar[XB_TOP], 1u);
            const unsigned tg = og / nx;
            if (og + 1u == (tg + 1u) * nx) xb_add(&bar[XB_TOPGEN], 1u);
            else XB_SPIN(xb_ld(&bar[XB_TOPGEN]) == tg, bar);
            __builtin_amdgcn_fence(__ATOMIC_ACQUIRE, "agent");
            xb_add(&bar[XB_XGEN(bx)], 1u);
            asm volatile("s_waitcnt vmcnt(0)" ::: "memory");
        } else {
            XB_SPIN(xb_ld(&bar[XB_XGEN(bx)]) == gen, bar);
            __builtin_amdgcn_fence(__ATOMIC_ACQUIRE, "agent");
            asm volatile("s_waitcnt vmcnt(0)" ::: "memory");
        }
    }
    __syncthreads();
}

constexpr int LDS_BYTES = 131072 + 8192;
__global__ void __launch_bounds__(512, 2) fwd_kernel(Args a) {
    extern __shared__ __attribute__((aligned(16))) unsigned char lds_raw[];
    LAS unsigned char* lds = (LAS unsigned char*)lds_raw;
    cg::grid_group grid = cg::this_grid();
    grid.sync();
    if (threadIdx.x < 16) ((volatile LAS unsigned*)(lds + 131072))[threadIdx.x] = 0u;
    __syncthreads();
    xcd_barrier_post((unsigned*)a.ws);
#define GRID_SYNC() xcd_barrier((unsigned*)a.ws, (volatile LAS unsigned*)(lds + 131072 + 32))
    const int tid = threadIdx.x, lane = tid & 63, wave = __builtin_amdgcn_readfirstlane(tid >> 6);
    const int G = gridDim.x, gw = blockIdx.x * 8 + wave, NGW = G * 8;
    unsigned char* ws = a.ws;
    float* ss = (float*)(ws + WS_SS);
    bf16_t* XB = (bf16_t*)(ws + WS_XB); bf16_t* H = (bf16_t*)(ws + WS_BIG);
    bf16_t* Mb = (bf16_t*)(ws + WS_U);

    prologue(a, lds, gw, NGW, lane, wave);
    GRID_SYNC();

#pragma unroll 1
    for (int l = 0; l < DEPTH; ++l) {
        const unsigned char* wl = ws + WS_W + (size_t)l * LW_BYTES;
        pg8::StaticOrder S;
        {
            pg8::Gemm g{XB, (const bf16_t*)(wl + LW_GU1), M, NGU, DM}; S.init(M, NGU, G, (int)blockIdx.x);
            EpiGU E{H, ss};
            pg8::gemm_phase<EpiGU, true>(lds, g, S, E);
        }
        GRID_SYNC();
        {
            pg8::Gemm g{H, (const bf16_t*)(wl + LW_D1), M, DM, FF}; S.init(M, DM, G, (int)blockIdx.x);
            EpiResid E{l == 0 ? a.x : a.out, a.out, XB, ss, 0.5f};
            pg8::gemm_phase<EpiResid, true>(lds, g, S, E);
        }
        GRID_SYNC();
        {
            pg8::Gemm g{XB, (const bf16_t*)(wl + LW_IN), M, NIN, DM}; S.init(M, NIN, G, (int)blockIdx.x);
            EpiWin E{ss, (bf16_t*)(ws + WS_U), (bf16_t*)(ws + WS_Q), (bf16_t*)(ws + WS_K), (bf16_t*)(ws + WS_VT), (bf16_t*)(ws + WS_G),
                     a.qn + l * 64, a.kn + l * 64, (const float*)(ws + WS_ROPE)};
            pg8::gemm_phase<EpiWin, true>(lds, g, S, E);
        }
        GRID_SYNC();
        mixer_phase(a, l, gw, NGW, lane);
        GRID_SYNC();
        {
            S.init(M, DM, G, (int)blockIdx.x);
            pg8::Gemm g1{(const bf16_t*)(ws + WS_DP), (const bf16_t*)(wl + LW_PB), M, DM, PD};
            EpiBranch<false> E1{Mb, (const bf16_t*)(ws + WS_G)};
            pg8::gemm_phase<EpiBranch<false>, true>(lds, g1, S, E1);
            pg8::Gemm g2{(const bf16_t*)(ws + WS_OA), (const bf16_t*)(wl + LW_AB), M, DM, AD};
            EpiBranch<true> E2{Mb, (const bf16_t*)(ws + WS_G)};
            pg8::gemm_phase<EpiBranch<true>, true>(lds, g2, S, E2);
        }
        GRID_SYNC();
        {
            pg8::Gemm g{Mb, (const bf16_t*)(wl + LW_OUT), M, DM, DM}; S.init(M, DM, G, (int)blockIdx.x);
            EpiResid E{a.out, a.out, XB, ss, 1.0f};
            pg8::gemm_phase<EpiResid, true>(lds, g, S, E);
        }
        GRID_SYNC();
        {
            pg8::Gemm g{XB, (const bf16_t*)(wl + LW_GU2), M, NGU, DM}; S.init(M, NGU, G, (int)blockIdx.x);
            EpiGU E{H, ss};
            pg8::gemm_phase<EpiGU, true>(lds, g, S, E);
        }
        GRID_SYNC();
        {
            pg8::Gemm g{H, (const bf16_t*)(wl + LW_D2), M, DM, FF}; S.init(M, DM, G, (int)blockIdx.x);
            EpiResid E{a.out, a.out, l < DEPTH - 1 ? XB : nullptr, l < DEPTH - 1 ? ss : nullptr, 0.5f};
            pg8::gemm_phase<EpiResid, true>(lds, g, S, E);
        }
        if (l < DEPTH - 1) GRID_SYNC();
    }
}

extern "C" void kernel_launch(void* const* d_in, const int* in_sizes, int n_in, void* d_out, int out_size, void* d_ws, size_t ws_size, hipStream_t stream) {
    static int grid = 0;
    if (grid == 0) {
        if (n_in != 17 || in_sizes[0] != M * DM || out_size != M * DM || ws_size < WS_END) { fprintf(stderr, "kernel_launch: unexpected shapes (n_in %d, in0 %d, out %d, ws %zu)\n", n_in, n_in > 0 ? in_sizes[0] : -1, out_size, ws_size); grid = -1; return; }
        int dev = 0, cus = 0, per_cu = 0;
        if (hipGetDevice(&dev) != hipSuccess || hipDeviceGetAttribute(&cus, hipDeviceAttributeMultiprocessorCount, dev) != hipSuccess) { grid = -1; return; }
        if (hipFuncSetAttribute((const void*)fwd_kernel, hipFuncAttributeMaxDynamicSharedMemorySize, LDS_BYTES) != hipSuccess) { fprintf(stderr, "kernel_launch: hipFuncSetAttribute failed\n"); grid = -1; return; }
        if (hipOccupancyMaxActiveBlocksPerMultiprocessor(&per_cu, (const void*)fwd_kernel, 512, LDS_BYTES) != hipSuccess || per_cu < 1) per_cu = 1;
        (void)hipGetLastError();
        grid = cus * per_cu;
    }
    if (grid < 0) return;
    Args a{};
    a.x = (const float*)d_in[0]; a.ln1 = (const float*)d_in[1]; a.wgu1 = (const float*)d_in[2]; a.wd1 = (const float*)d_in[3]; a.lnm = (const float*)d_in[4];
    a.win = (const float*)d_in[5]; a.poolw = (const float*)d_in[6]; a.pscale = (const float*)d_in[7]; a.wpb = (const float*)d_in[8]; a.qn = (const float*)d_in[9];
    a.kn = (const float*)d_in[10]; a.sinks = (const float*)d_in[11]; a.wab = (const float*)d_in[12]; a.wout = (const float*)d_in[13]; a.ln2 = (const float*)d_in[14];
    a.wgu2 = (const float*)d_in[15]; a.wd2 = (const float*)d_in[16];
    a.out = (float*)d_out; a.ws = (unsigned char*)d_ws;
    void* args[] = {&a};
    if (hipMemsetAsync(d_ws, 0, 16384, stream) != hipSuccess) { fprintf(stderr, "kernel_launch: hipMemsetAsync failed\n"); return; }
    const hipError_t e = hipLaunchCooperativeKernel((const void*)fwd_kernel, dim3(grid), dim3(512), args, LDS_BYTES, stream);
    if (e != hipSuccess) fprintf(stderr, "kernel_launch: cooperative launch failed: %s (grid %d)\n", hipGetErrorString(e), grid);
}
```

```cpp
#include <hip/hip_runtime.h>
#include <hip/hip_cooperative_groups.h>
#include <cstdio>
#include <cstdint>
namespace cg = cooperative_groups;

namespace pg8 {
#define PG8_LAS __attribute__((address_space(3)))
typedef unsigned short bf16_t;
typedef short bf16x8 __attribute__((ext_vector_type(8)));
typedef float f32x4 __attribute__((ext_vector_type(4)));
typedef unsigned u32x4 __attribute__((ext_vector_type(4)));
typedef unsigned u32x2 __attribute__((ext_vector_type(2)));
constexpr int BM = 256, BK = 64, HALF = 128, HTB = HALF * BK * 2, STAGE_BYTES = 8 * HTB, NXCD = 8, WGM = 8;

__host__ __device__ __forceinline__ int lds_byte(int r, int c) { const int st = (r >> 4) * 2 + (c >> 5), rr = r & 15, cc = c & 31, ob = rr * 64 + cc * 2; return st * 1024 + (ob ^ (((ob >> 9) & 1) << 5)); }
__host__ __device__ __forceinline__ void stage_rc(int b, int& R, int& C) { const int st = b / 1024, sb = b % 1024, swz = sb ^ (((sb >> 9) & 1) << 5); R = (st >> 1) * 16 + swz / 64; C = (st & 1) * 32 + (swz % 64) / 2; }
__host__ __device__ __forceinline__ int perm32(int rho) { const int n = rho >> 4, i = rho & 15; return 8 * (i >> 2) + 4 * n + (i & 3); }

struct Unit { int pm, pn; };
struct Gemm { const bf16_t* A; const bf16_t* Bt; int M, N, K; };

struct StaticOrder {
    int nM, nN, nwg, G, c;
    __host__ __device__ void init(int M, int N, int G_, int c_) { nM = M / BM; nN = N / BM; nwg = nM * nN; G = G_; c = c_; }
    __host__ __device__ bool next(int i, Unit& u) const {
        const long L = (long)i * G + c; if (L >= nwg) return false;
        int wgid = (int)L; { const int q = nwg / NXCD, r = nwg % NXCD, xcd = wgid % NXCD, off = wgid / NXCD; wgid = (xcd < r ? xcd * (q + 1) : r * (q + 1) + (xcd - r) * q) + off; }
        const int nig = WGM * nN, gid = wgid / nig, fm = gid * WGM, gsz = (nM - fm) < WGM ? (nM - fm) : WGM;
        u.pm = fm + ((wgid % nig) % gsz); u.pn = (wgid % nig) / gsz; return true;
    }
};

__device__ __forceinline__ unsigned cvt_pk_bf16(float lo, float hi) { unsigned r; asm volatile("v_cvt_pk_bf16_f32 %0, %1, %2" : "=v"(r) : "v"(lo), "v"(hi)); return r; }

template <class Epi, bool ALIGN_EPI, bool ABLK = false>
__device__ __forceinline__ void gemm_phase(PG8_LAS unsigned char* lds, const Gemm g, const StaticOrder& S, const Epi& E) {
    int tid = threadIdx.x; asm volatile("" : "+v"(tid));
    const int wid = __builtin_amdgcn_readfirstlane(tid >> 6), lane = tid & 63, wr = wid >> 2, wc = wid & 3, fr = lane & 15, fq = lane >> 4;
    const int K = g.K, nt = K / BK;
    unsigned voffA[2], voffB[2];
#pragma unroll
    for (int i = 0; i < 2; ++i) { int R, C; stage_rc(tid * 16 + i * 8192, R, C); const int Rb = (R & ~31) + perm32(R & 31);
        voffA[i] = (unsigned)(R * (ABLK ? BK : K) + C) * 2u; voffB[i] = (unsigned)(Rb * K + C) * 2u; }
    const size_t kstep = (size_t)(BK * 2);
    const size_t hstep = (size_t)HALF * K * 2;
    const size_t tstep = 2 * hstep;
    const size_t kstepA = ABLK ? (size_t)(BM * BK * 2) : kstep, hstepA = ABLK ? (size_t)(HALF * BK * 2) : hstep;
    const unsigned ldsw = (unsigned)wid * 1024u;
    const int aoff = lds_byte(wr * 64 + fr, fq * 8), boff = lds_byte(wc * 32 + fr, fq * 8);
#define PG8_SA(b, h) (((b) * 2 + (h)) * HTB)
#define PG8_SB(b, h) ((4 + (b) * 2 + (h)) * HTB)
#define PG8_STAGE(bufoff, gbase, voff) do { _Pragma("unroll") for (int _i = 0; _i < 2; ++_i) \
        __builtin_amdgcn_global_load_lds((const unsigned*)((const char*)(gbase) + (voff)[_i]), (PG8_LAS unsigned*)(lds + (bufoff) + ldsw + _i * 8192), 16, 0, 0); } while (0)
#define PG8_LDA(dst, b, h) do { _Pragma("unroll") for (int m = 0; m < 4; ++m) _Pragma("unroll") for (int k = 0; k < 2; ++k) dst[m][k] = *(const PG8_LAS bf16x8*)(lds + PG8_SA(b, h) + aoff + m * 2048 + k * 1024); } while (0)
#define PG8_LDB(dst, b, h) do { _Pragma("unroll") for (int n = 0; n < 2; ++n) _Pragma("unroll") for (int k = 0; k < 2; ++k) dst[n][k] = *(const PG8_LAS bf16x8*)(lds + PG8_SB(b, h) + boff + n * 2048 + k * 1024); } while (0)
#define PG8_MMA(ai, bj, At, Bt) do { __builtin_amdgcn_s_setprio(1); _Pragma("unroll") for (int m = 0; m < 4; ++m) _Pragma("unroll") for (int n = 0; n < 2; ++n) _Pragma("unroll") for (int k = 0; k < 2; ++k) \
        acc[ai][bj][m][n] = __builtin_amdgcn_mfma_f32_16x16x32_bf16(Bt[n][k], At[m][k], acc[ai][bj][m][n], 0, 0, 0); __builtin_amdgcn_s_setprio(0); } while (0)
#define PG8_WAIT_V(n) asm volatile("s_waitcnt vmcnt(" #n ")" ::: "memory")
#define PG8_WAIT_L(n) asm volatile("s_waitcnt lgkmcnt(" #n ")" ::: "memory")
#define PG8_BAR __builtin_amdgcn_s_barrier()
#define PG8_SCHED __builtin_amdgcn_sched_barrier(0)
    Unit cur, nxt; int ui = 0;
    if (!S.next(0, cur)) return;
    f32x4 acc[2][2][4][2];
#pragma unroll
    for (int a = 0; a < 2; ++a)
#pragma unroll
        for (int b = 0; b < 2; ++b)
#pragma unroll
            for (int m = 0; m < 4; ++m)
#pragma unroll
                for (int n = 0; n < 2; ++n) acc[a][b][m][n] = (f32x4){0.f, 0.f, 0.f, 0.f};
    bf16x8 At[4][2], B0[2][2], B1[2][2];
    typedef float f32x2 __attribute__((ext_vector_type(2)));
    f32x2 rsp = (f32x2){0.f, 0.f};
    PG8_LAS float* rsbuf = (PG8_LAS float*)(lds + STAGE_BYTES + 1024);
    const char* cA = (const char*)g.A + (size_t)cur.pm * tstep; const char* cB = (const char*)g.Bt + (size_t)cur.pn * tstep;
    PG8_STAGE(PG8_SB(0, 0), cB, voffB); PG8_STAGE(PG8_SB(0, 1), cB + hstep, voffB); PG8_STAGE(PG8_SA(0, 0), cA, voffA); PG8_STAGE(PG8_SA(0, 1), cA + hstepA, voffA);
    if (wr == 1) PG8_BAR;
    PG8_WAIT_V(2); PG8_BAR;
    PG8_STAGE(PG8_SB(1, 0), cB + kstep, voffB); PG8_STAGE(PG8_SA(1, 0), cA + kstepA, voffA); PG8_STAGE(PG8_SB(1, 1), cB + hstep + kstep, voffB);
    PG8_WAIT_V(6); PG8_BAR;
    for (;;) {
        const bool has_next = S.next(ui + 1, nxt);
        const char* nA = has_next ? (const char*)g.A + (size_t)nxt.pm * tstep : cA; const char* nB = has_next ? (const char*)g.Bt + (size_t)nxt.pn * tstep : cB;
        for (int t = 0; t < nt; t += 2) {
            const bool last = (t == nt - 2);
            const char* a1 = cA + (size_t)(t + 1) * kstepA;
            const char* a2 = last ? nA : cA + (size_t)(t + 2) * kstepA; const char* b2 = last ? nB : cB + (size_t)(t + 2) * kstep;
            const char* a3 = a2 + kstepA; const char* b3 = b2 + kstep;
            if constexpr (Epi::NEEDS_RS) { if (last) rsp = *(const f32x2*)(E.ss + ((size_t)(cur.pm * BM + (tid >> 1)) * 4 + (tid & 1) * 2)); }
            PG8_LDB(B0, 0, 0); PG8_LDB(B1, 0, 1); PG8_SCHED; PG8_LDA(At, 0, 0); PG8_STAGE(PG8_SA(1, 1), a1 + hstepA, voffA);
            PG8_WAIT_V(8); PG8_WAIT_L(0); PG8_BAR; PG8_MMA(0, 0, At, B0); PG8_MMA(0, 1, At, B1); PG8_BAR; PG8_SCHED;
            PG8_LDA(At, 0, 1); PG8_STAGE(PG8_SB(0, 0), b2, voffB); PG8_STAGE(PG8_SB(0, 1), b2 + hstep, voffB); PG8_STAGE(PG8_SA(0, 0), a2, voffA);
            PG8_WAIT_V(8); PG8_WAIT_L(0); PG8_BAR; PG8_MMA(1, 0, At, B0); PG8_MMA(1, 1, At, B1); PG8_BAR; PG8_SCHED;
            PG8_LDB(B0, 1, 0); PG8_LDB(B1, 1, 1); PG8_SCHED; PG8_LDA(At, 1, 0); PG8_STAGE(PG8_SA(0, 1), a2 + hstepA, voffA);
            PG8_WAIT_V(8); PG8_WAIT_L(0); PG8_BAR; PG8_MMA(0, 0, At, B0); PG8_MMA(0, 1, At, B1); PG8_BAR; PG8_SCHED;
            PG8_LDA(At, 1, 1); PG8_STAGE(PG8_SB(1, 0), b3, voffB); PG8_STAGE(PG8_SB(1, 1), b3 + hstep, voffB); PG8_STAGE(PG8_SA(1, 0), a3, voffA);
            PG8_WAIT_V(8); PG8_WAIT_L(0); PG8_BAR; PG8_MMA(1, 0, At, B0); PG8_MMA(1, 1, At, B1); PG8_BAR; PG8_SCHED;
        }
        if constexpr (ALIGN_EPI) { if (wr == 0) PG8_BAR; }
        if constexpr (Epi::NEEDS_RS) {
            float sq = rsp[0] + rsp[1];
            sq += __shfl_xor(sq, 1);
            if ((tid & 1) == 0) rsbuf[tid >> 1] = __builtin_amdgcn_rsqf(sq * (1.f / 1024.f) + 1e-6f);
            PG8_WAIT_L(0); PG8_BAR; asm volatile("" ::: "memory");
        }
        E(acc, cur, wr, wc, fr, fq, rsbuf);
        if (!has_next) break;
#pragma unroll
        for (int a = 0; a < 2; ++a)
#pragma unroll
            for (int b = 0; b < 2; ++b)
#pragma unroll
                for (int m = 0; m < 4; ++m)
#pragma unroll
                    for (int n = 0; n < 2; ++n) acc[a][b][m][n] = (f32x4){0.f, 0.f, 0.f, 0.f};
        cur = nxt; cA = nA; cB = nB; ++ui;
        if constexpr (ALIGN_EPI) { if (wr == 1) PG8_BAR; }
    }
    PG8_WAIT_V(0);
    if constexpr (!ALIGN_EPI) { if (wr == 0) PG8_BAR; }
    PG8_BAR;
#undef PG8_SA
#undef PG8_SB
#undef PG8_STAGE
#undef PG8_LDA
#undef PG8_LDB
#undef PG8_MMA
#undef PG8_WAIT_V
#undef PG8_WAIT_L
#undef PG8_BAR
#undef PG8_SCHED
}
}

using pg8::bf16_t; using pg8::bf16x8; using pg8::f32x4; using pg8::u32x4; using pg8::u32x2; using pg8::Unit; using pg8::cvt_pk_bf16;
typedef float f32x16 __attribute__((ext_vector_type(16)));
#define LAS __attribute__((address_space(3)))

constexpr int DM = 1024, NB = 8, SEQ = 8192, DEPTH = 4, M = NB * SEQ;
constexpr int FF = 2816, NGU = 2 * FF, NIN = 3328, PD = 512, AD = 512, KVD = 128;
constexpr float EPSN = 1e-6f, LOG2E = 1.4426950408889634f;
constexpr float QSCALE = 0.125f * LOG2E;

constexpr size_t MiB = 1u << 20;
constexpr size_t WS_ROPE = 1 * MiB;
constexpr size_t WS_SS = 2 * MiB;
constexpr size_t WS_W = 8 * MiB;
constexpr size_t LW_GU1 = 0, LW_D1 = 11 * MiB, LW_IN = LW_D1 + 11 * MiB / 2, LW_PB = LW_IN + 13 * MiB / 2, LW_AB = LW_PB + 1 * MiB,
                 LW_OUT = LW_AB + 1 * MiB, LW_GU2 = LW_OUT + 2 * MiB, LW_D2 = LW_GU2 + 11 * MiB, LW_BYTES = LW_D2 + 11 * MiB / 2;
static_assert(LW_BYTES == 87 * MiB / 2, "weights per layer");
constexpr size_t WS_XB = 184 * MiB;
constexpr size_t WS_DP = 312 * MiB;
constexpr size_t WS_OA = 376 * MiB;
constexpr size_t WS_BIG = 440 * MiB;
constexpr size_t WS_U = WS_BIG, WS_Q = WS_U + 64 * MiB, WS_K = WS_Q + 64 * MiB, WS_VT = WS_K + 16 * MiB, WS_G = WS_VT + 16 * MiB, WS_END = WS_G + 256 * MiB;
static_assert(WS_W + 4 * LW_BYTES <= WS_XB && WS_BIG + (size_t)M * FF * 2 <= WS_END && WS_END <= 1024 * MiB, "d_ws map");

__device__ __forceinline__ float bf_lo(unsigned w) { return __uint_as_float(w << 16); }
__device__ __forceinline__ float bf_hi(unsigned w) { return __uint_as_float(w & 0xffff0000u); }
__device__ __forceinline__ u32x4 pack8(const f32x4 a, const f32x4 b) { u32x4 w; w.x = cvt_pk_bf16(a[0], a[1]); w.y = cvt_pk_bf16(a[2], a[3]); w.z = cvt_pk_bf16(b[0], b[1]); w.w = cvt_pk_bf16(b[2], b[3]); return w; }

struct EpiGU {
    static constexpr bool NEEDS_RS = true;
    bf16_t* H; const float* ss;
    __device__ __forceinline__ void operator()(const f32x4 (&acc)[2][2][4][2], const Unit& u, int wr, int wc, int fr, int fq, const PG8_LAS float* rsbuf) const {
        bf16_t* hb = H + ((size_t)(u.pm * (FF / 64) + 2 * u.pn + (wc >> 1)) * 256 + wr * 64 + fr) * 64 + (wc & 1) * 32 + 8 * fq;
#pragma unroll
        for (int ai = 0; ai < 2; ++ai)
#pragma unroll
            for (int m = 0; m < 4; ++m) {
                const float rs = rsbuf[ai * 128 + wr * 64 + m * 16 + fr];
                const float c1 = -LOG2E * rs, rs2 = rs * rs;
                f32x4 h[2];
#pragma unroll
                for (int n = 0; n < 2; ++n) { const f32x4 ag = acc[ai][0][m][n], au = acc[ai][1][m][n];
                    const f32x4 t = ag * c1; f32x4 e;
#pragma unroll
                    for (int k = 0; k < 4; ++k) e[k] = __builtin_amdgcn_exp2f(t[k]);
                    const f32x4 d = e + 1.0f; f32x4 r;
#pragma unroll
                    for (int k = 0; k < 4; ++k) r[k] = __builtin_amdgcn_rcpf(d[k]);
                    h[n] = ((ag * au) * rs2) * r; }
                *(u32x4*)(hb + (ai * 128 + m * 16) * 64) = pack8(h[0], h[1]);
            }
    }
};

struct EpiResid {
    static constexpr bool NEEDS_RS = false;
    bf16_t* xb; float* outf; float* ss_out; float scale;
    __device__ __forceinline__ void operator()(const f32x4 (&acc)[2][2][4][2], const Unit& u, int wr, int wc, int fr, int fq, const PG8_LAS float* rsbuf) const {
        const int row0 = u.pm * 256 + wr * 64 + fr, col0 = u.pn * 256 + wc * 32 + 8 * fq;
        PG8_LAS float* sqbuf = (PG8_LAS float*)(rsbuf + 256);
#pragma unroll
        for (int ai = 0; ai < 2; ++ai)
#pragma unroll
            for (int m = 0; m < 4; ++m) {
                const int row = row0 + ai * 128 + m * 16; float sq = 0.f;
#pragma unroll
                for (int bj = 0; bj < 2; ++bj) { const size_t off = (size_t)row * DM + col0 + bj * 128;
                    const u32x4 xw = *(const u32x4*)(xb + off);
                    const f32x4 v0 = (f32x4){bf_lo(xw.x), bf_hi(xw.x), bf_lo(xw.y), bf_hi(xw.y)} + acc[ai][bj][m][0] * scale;
                    const f32x4 v1 = (f32x4){bf_lo(xw.z), bf_hi(xw.z), bf_lo(xw.w), bf_hi(xw.w)} + acc[ai][bj][m][1] * scale;
                    if (outf) { *(f32x4*)(outf + off) = v0; *(f32x4*)(outf + off + 4) = v1; }
                    else { const u32x4 w = pack8(v0, v1); *(u32x4*)(xb + off) = w;
                        const f32x4 r0 = (f32x4){bf_lo(w.x), bf_hi(w.x), bf_lo(w.y), bf_hi(w.y)}, r1 = (f32x4){bf_lo(w.z), bf_hi(w.z), bf_lo(w.w), bf_hi(w.w)};
                        sq += (r0[0] * r0[0] + r0[1] * r0[1]) + (r0[2] * r0[2] + r0[3] * r0[3]) + (r1[0] * r1[0] + r1[1] * r1[1]) + (r1[2] * r1[2] + r1[3] * r1[3]); } }
                if (ss_out) { sq += __shfl_xor(sq, 16); sq += __shfl_xor(sq, 32);
                    if (fq == 0) sqbuf[(ai * 128 + wr * 64 + m * 16 + fr) * 4 + wc] = sq; }
            }
        if (ss_out) {
            asm volatile("s_waitcnt lgkmcnt(0)" ::: "memory"); __builtin_amdgcn_s_barrier(); asm volatile("" ::: "memory");
            const int t = (wr * 4 + wc) * 64 + fq * 16 + fr;
            if (t < 256) { const f32x4 p = *(const PG8_LAS f32x4*)(sqbuf + t * 4); ss_out[(size_t)(u.pm * 256 + t) * 4 + u.pn] = (p[0] + p[1]) + (p[2] + p[3]); }
        }
    }
};

struct EpiWin {
    static constexpr bool NEEDS_RS = true;
    const float* ss; bf16_t *U, *Q, *Kb, *VT, *G; const float *qn, *kn, *rope;
    __device__ __forceinline__ void operator()(const f32x4 (&acc)[2][2][4][2], const Unit& u, int wr, int wc, int fr, int fq, const PG8_LAS float* rsbuf) const {
        const int row0 = u.pm * 256 + wr * 64 + fr, pn = u.pn;
        if (pn < 2 || pn >= 5) {
            const bool sig = pn >= 5;
            bf16_t* dst = sig ? G + (pn - 5) * 256 : U + pn * 256; const int ld = sig ? 2048 : 512;
            dst += wc * 32 + 8 * fq;
#pragma unroll
            for (int ai = 0; ai < 2; ++ai)
#pragma unroll
                for (int m = 0; m < 4; ++m) {
                    const int row = row0 + ai * 128 + m * 16;
                    const float rs = rsbuf[ai * 128 + wr * 64 + m * 16 + fr];
#pragma unroll
                    for (int bj = 0; bj < 2; ++bj) { f32x4 v0 = acc[ai][bj][m][0] * rs, v1 = acc[ai][bj][m][1] * rs;
                        if (sig) {
#pragma unroll
                            for (int e = 0; e < 4; ++e) { v0[e] = __builtin_amdgcn_rcpf(1.f + __builtin_amdgcn_exp2f(-LOG2E * v0[e])); v1[e] = __builtin_amdgcn_rcpf(1.f + __builtin_amdgcn_exp2f(-LOG2E * v1[e])); } }
                        *(u32x4*)(dst + (size_t)row * ld + bj * 128) = pack8(v0, v1); }
                }
        } else if (pn < 4 || wc < 2) {
            const bool isq = pn < 4;
            const float* gain = isq ? qn : kn;
            const f32x4 g00 = *(const f32x4*)(gain + (fq < 2 ? 4 * fq : 8 * fq)), g01 = *(const f32x4*)(gain + (fq < 2 ? 4 * fq + 8 : 8 * fq + 4));
            const f32x4 g10 = *(const f32x4*)(gain + 32 + 8 * fq), g11 = *(const f32x4*)(gain + 36 + 8 * fq);
            const float osc = isq ? QSCALE : 1.f;
            bf16_t* dst = isq ? Q + (4 * (pn - 2) + wc) * 64 : Kb + wc * 64; const int ld = isq ? AD : KVD;
            dst += 8 * fq;
#pragma unroll
            for (int ai = 0; ai < 2; ++ai)
#pragma unroll
                for (int m = 0; m < 4; ++m) {
                    const int row = row0 + ai * 128 + m * 16;
                    const float rs = rsbuf[ai * 128 + wr * 64 + m * 16 + fr];
                    f32x4 a = acc[ai][0][m][0] * rs, b = acc[ai][0][m][1] * rs, c = acc[ai][1][m][0] * rs, d = acc[ai][1][m][1] * rs;
                    float sq = (a[0] * a[0] + a[1] * a[1]) + (a[2] * a[2] + a[3] * a[3]) + (b[0] * b[0] + b[1] * b[1]) + (b[2] * b[2] + b[3] * b[3])
                             + (c[0] * c[0] + c[1] * c[1]) + (c[2] * c[2] + c[3] * c[3]) + (d[0] * d[0] + d[1] * d[1]) + (d[2] * d[2] + d[3] * d[3]);
                    sq += __shfl_xor(sq, 16); sq += __shfl_xor(sq, 32);
                    const float rq = __builtin_amdgcn_rsqf(sq * (1.f / 64.f) + EPSN);
                    a = a * rq * g00; b = b * rq * g01; c = c * (rq * osc) * g10; d = d * (rq * osc) * g11;
                    const int t = row & (SEQ - 1);
                    const f32x4 cs = *(const f32x4*)(rope + t * 16 + 4 * (fq & 1)), sn = *(const f32x4*)(rope + t * 16 + 8 + 4 * (fq & 1));
                    const f32x4 ra = a * cs - b * sn, rb = b * cs + a * sn;
                    if (fq < 2) { a = ra; b = rb; }
                    a = a * osc; b = b * osc;
                    *(u32x4*)(dst + (size_t)row * ld) = pack8(a, b);
                    *(u32x4*)(dst + (size_t)row * ld + 32) = pack8(c, d);
                    if (m & 1) asm volatile("" ::: "memory");
                }
        } else {
            const int hv = wc - 2;
#pragma unroll
            for (int ai = 0; ai < 2; ++ai)
#pragma unroll
                for (int m = 0; m < 4; ++m) {
                    const int row = row0 + ai * 128 + m * 16;
                    const float rs = rsbuf[ai * 128 + wr * 64 + m * 16 + fr];
                    bf16_t* vb = VT + ((size_t)((row >> 13) * 2 + hv) * 64 + 8 * fq) * SEQ + (row & (SEQ - 1));
#pragma unroll
                    for (int bj = 0; bj < 2; ++bj)
#pragma unroll
                        for (int n = 0; n < 2; ++n) { const f32x4 v = acc[ai][bj][m][n] * rs;
                            const unsigned w0 = cvt_pk_bf16(v[0], v[1]), w1 = cvt_pk_bf16(v[2], v[3]);
                            bf16_t* p = vb + (size_t)(32 * bj + 4 * n) * SEQ;
                            p[0] = (bf16_t)(w0 & 0xffffu); p[SEQ] = (bf16_t)(w0 >> 16); p[2 * SEQ] = (bf16_t)(w1 & 0xffffu); p[3 * SEQ] = (bf16_t)(w1 >> 16); }
                }
        }
    }
};

template <bool SECOND> struct EpiBranch {
    static constexpr bool NEEDS_RS = false;
    bf16_t* Mb; const bf16_t* G;
    __device__ __forceinline__ void operator()(const f32x4 (&acc)[2][2][4][2], const Unit& u, int wr, int wc, int fr, int fq, const PG8_LAS float* rsbuf) const {
        const int row0 = u.pm * 256 + wr * 64 + fr, col0 = u.pn * 256 + wc * 32 + 8 * fq;
#pragma unroll
        for (int ai = 0; ai < 2; ++ai)
#pragma unroll
            for (int m = 0; m < 4; ++m) {
                const int row = row0 + ai * 128 + m * 16;
#pragma unroll
                for (int bj = 0; bj < 2; ++bj) { const int col = col0 + bj * 128;
                    const u32x4 gw = *(const u32x4*)(G + (size_t)row * 2048 + (SECOND ? 1024 : 0) + col);
                    f32x4 v0 = acc[ai][bj][m][0] * (f32x4){bf_lo(gw.x), bf_hi(gw.x), bf_lo(gw.y), bf_hi(gw.y)};
                    f32x4 v1 = acc[ai][bj][m][1] * (f32x4){bf_lo(gw.z), bf_hi(gw.z), bf_lo(gw.w), bf_hi(gw.w)};
                    bf16_t* mp = Mb + (size_t)row * DM + col;
                    if (SECOND) { const u32x4 pw = *(const u32x4*)mp;
                        v0 = v0 + (f32x4){bf_lo(pw.x), bf_hi(pw.x), bf_lo(pw.y), bf_hi(pw.y)}; v1 = v1 + (f32x4){bf_lo(pw.z), bf_hi(pw.z), bf_lo(pw.w), bf_hi(pw.w)}; }
                    *(u32x4*)mp = pack8(v0, v1); }
            }
    }
};

__device__ __forceinline__ int sigma_inv4(int d4) { return d4 < 16 ? 8 * ((d4 >> 2) & 1) + 4 * (d4 >> 3) : d4; }
template <int MODE> __device__ __forceinline__ int src_group(int n0, bool& perm) {
    perm = false;
    if (MODE == 0) return n0;
    if (MODE == 1) { const int tile = n0 >> 8, loc = n0 & 255; return loc < 128 ? tile * 128 + loc : FF + tile * 128 + (loc - 128); }
    if (n0 < 512 || n0 >= 1280) return n0;
    const int pn = n0 >> 8, loc = n0 & 255, bj = loc >> 7, wc = (loc & 127) >> 5;
    if (pn < 4) { perm = (bj == 0); return 512 + (4 * (pn - 2) + wc) * 64 + 32 * bj; }
    if (wc < 2) { perm = (bj == 0); return 1024 + 64 * wc + 32 * bj; }
    return 1152 + 64 * (wc - 2) + 32 * bj;
}
struct TItem { const float* W; const float* gain; bf16_t* WT; int K, N, mode, r; };
__device__ __forceinline__ int src_group_rt(int mode, int n0, bool& perm) { if (mode == 1) return src_group<1>(n0, perm); if (mode == 2) return src_group<2>(n0, perm); return src_group<0>(n0, perm); }
__device__ __forceinline__ void titem_load(const TItem& t, int lane, f32x4 (&v)[8], int& jd) {
    const int nblk = t.N / 32, kb = t.r / nblk, nb = t.r % nblk, k0 = 64 * kb, n0 = 32 * nb;
    bool perm; const int src = src_group_rt(t.mode, n0, perm);
    const int c4 = 4 * (lane & 7); jd = perm ? sigma_inv4(c4) : c4;
#pragma unroll
    for (int i = 0; i < 8; ++i) { const int kk = 8 * i + (lane >> 3);
        v[i] = *(const f32x4*)(t.W + (size_t)(k0 + kk) * t.N + src + c4);
        if (t.gain) v[i] = v[i] * t.gain[k0 + kk]; }
}
__device__ __forceinline__ void titem_store(const TItem& t, LAS float* scr, int lane, const f32x4 (&v)[8], int jd) {
    const int nblk = t.N / 32, kb = t.r / nblk, nb = t.r % nblk, k0 = 64 * kb, n0 = 32 * nb;
#pragma unroll
    for (int i = 0; i < 8; ++i) { const int kk = 8 * i + (lane >> 3); LAS float* s = scr + kk * 33 + jd; s[0] = v[i][0]; s[1] = v[i][1]; s[2] = v[i][2]; s[3] = v[i][3]; }
    asm volatile("s_waitcnt lgkmcnt(0)" ::: "memory");
    const int c = lane & 7;
#pragma unroll
    for (int j = 0; j < 4; ++j) { const int n = (lane >> 3) + 8 * j; const LAS float* s = scr + (8 * c) * 33 + n;
        u32x4 o; o.x = cvt_pk_bf16(s[0 * 33], s[1 * 33]); o.y = cvt_pk_bf16(s[2 * 33], s[3 * 33]); o.z = cvt_pk_bf16(s[4 * 33], s[5 * 33]); o.w = cvt_pk_bf16(s[6 * 33], s[7 * 33]);
        *(u32x4*)(t.WT + (size_t)(n0 + n) * t.K + k0 + 8 * c) = o; }
    asm volatile("s_waitcnt lgkmcnt(0)" ::: "memory");
}

struct Args {
    const float *x, *ln1, *wgu1, *wd1, *lnm, *win, *poolw, *pscale, *wpb, *qn, *kn, *sinks, *wab, *wout, *ln2, *wgu2, *wd2;
    float* out; unsigned char* ws;
};

__device__ __forceinline__ float wave_sum(float v) {
#pragma unroll
    for (int o = 1; o < 64; o <<= 1) v += __shfl_xor(v, o);
    return v;
}

__device__ __forceinline__ void prologue(const Args& a, LAS unsigned char* lds, int gw, int NGW, int lane, int wave) {
    LAS float* scr = (LAS float*)(lds + wave * 16384);
    unsigned char* ws = a.ws;
    constexpr int I_GU = (DM / 64) * (NGU / 32), I_D = (FF / 64) * (DM / 32), I_IN = (DM / 64) * (NIN / 32), I_AB = (AD / 64) * (DM / 32), I_OUT = (DM / 64) * (DM / 32);
    constexpr int I_LAYER = 2 * I_GU + 2 * I_D + I_IN + I_AB + I_OUT;
    auto resolve = [&](int it) {
        TItem t; const int l = it / I_LAYER; int r = it % I_LAYER;
        unsigned char* wl = ws + WS_W + (size_t)l * LW_BYTES;
        if (r < I_GU) { t = TItem{a.wgu1 + (size_t)l * DM * NGU, a.ln1 + l * DM, (bf16_t*)(wl + LW_GU1), DM, NGU, 1, r}; return t; } r -= I_GU;
        if (r < I_GU) { t = TItem{a.wgu2 + (size_t)l * DM * NGU, a.ln2 + l * DM, (bf16_t*)(wl + LW_GU2), DM, NGU, 1, r}; return t; } r -= I_GU;
        if (r < I_D) { t = TItem{a.wd1 + (size_t)l * FF * DM, nullptr, (bf16_t*)(wl + LW_D1), FF, DM, 0, r}; return t; } r -= I_D;
        if (r < I_D) { t = TItem{a.wd2 + (size_t)l * FF * DM, nullptr, (bf16_t*)(wl + LW_D2), FF, DM, 0, r}; return t; } r -= I_D;
        if (r < I_IN) { t = TItem{a.win + (size_t)l * DM * NIN, a.lnm + l * DM, (bf16_t*)(wl + LW_IN), DM, NIN, 2, r}; return t; } r -= I_IN;
        if (r < I_AB) { t = TItem{a.wab + (size_t)l * AD * DM, nullptr, (bf16_t*)(wl + LW_AB), AD, DM, 0, r}; return t; } r -= I_AB;
        t = TItem{a.wout + (size_t)l * DM * DM, nullptr, (bf16_t*)(wl + LW_OUT), DM, DM, 0, r}; return t;
    };
    for (int it = gw; it < DEPTH * I_LAYER; it += 2 * NGW) {
        const bool hasB = it + NGW < DEPTH * I_LAYER;
        const TItem A = resolve(it), B = resolve(hasB ? it + NGW : it);
        f32x4 va[8], vb[8]; int ja, jb;
        titem_load(A, lane, va, ja); titem_load(B, lane, vb, jb);
        titem_store(A, scr, lane, va, ja);
        if (hasB) titem_store(B, scr, lane, vb, jb);
    }
    for (int it = gw; it < DEPTH * 1024; it += NGW) {
        const int l = it >> 10, r = it & 1023, nb = r & 15, co = (r >> 4) & 15, g = r >> 8;
        const int n = nb * 64 + lane, c0 = co * 8;
        const float* pw = a.poolw + ((size_t)(l * 4 + g) * 128 + c0) * 128;
        const float* sc = a.pscale + l * PD + g * 128;
        const float* wp = a.wpb + ((size_t)l * PD + g * 128) * DM + n;
        float s[8] = {0.f, 0.f, 0.f, 0.f, 0.f, 0.f, 0.f, 0.f};
        for (int d = 0; d < 128; ++d) { const float w = sc[d] * wp[(size_t)d * DM];
#pragma unroll
            for (int i = 0; i < 8; ++i) s[i] += pw[i * 128 + d] * w; }
        u32x4 o; o.x = cvt_pk_bf16(s[0], s[1]); o.y = cvt_pk_bf16(s[2], s[3]); o.z = cvt_pk_bf16(s[4], s[5]); o.w = cvt_pk_bf16(s[6], s[7]);
        *(u32x4*)((bf16_t*)(ws + WS_W + (size_t)l * LW_BYTES + LW_PB) + (size_t)n * PD + g * 128 + c0) = o;
    }
    float* rope = (float*)(ws + WS_ROPE);
    for (int i = gw * 64 + lane; i < SEQ * 8; i += NGW * 64) { const int t = i >> 3, k = i & 7;
        const float inv = powf(500000.0f, -(float)(2 * k) / 16.0f); const float ang = (float)t * inv; float sn, cs; sincosf(ang, &sn, &cs);
        rope[t * 16 + k] = cs; rope[t * 16 + 8 + k] = sn; }
    float* ss = (float*)(ws + WS_SS);
    bf16_t* XB = (bf16_t*)(ws + WS_XB);
    for (int row0 = gw; row0 < M; row0 += 4 * NGW) {
        f32x4 v[4][4];
#pragma unroll
        for (int q = 0; q < 4; ++q) { const int row = row0 + q * NGW; const float* xr = a.x + (size_t)(row < M ? row : row0) * DM + 8 * lane;
#pragma unroll
            for (int j = 0; j < 2; ++j) { v[q][2 * j] = *(const f32x4*)(xr + 512 * j); v[q][2 * j + 1] = *(const f32x4*)(xr + 512 * j + 4); } }
#pragma unroll
        for (int q = 0; q < 4; ++q) { const int row = row0 + q * NGW; if (row >= M) break; float sq = 0.f;
#pragma unroll
            for (int j = 0; j < 2; ++j) { const f32x4 v0 = v[q][2 * j], v1 = v[q][2 * j + 1];
                sq += (v0[0] * v0[0] + v0[1] * v0[1]) + (v0[2] * v0[2] + v0[3] * v0[3]) + (v1[0] * v1[0] + v1[1] * v1[1]) + (v1[2] * v1[2] + v1[3] * v1[3]);
                *(u32x4*)(XB + (size_t)row * DM + 8 * lane + 512 * j) = pack8(v0, v1); }
            sq = wave_sum(sq);
            if (lane < 4) ss[(size_t)row * 4 + lane] = lane == 0 ? sq : 0.f; }
    }
}

__device__ __forceinline__ void unpack8(const u32x4 w, float (&f)[8]) { f[0] = bf_lo(w.x); f[1] = bf_hi(w.x); f[2] = bf_lo(w.y); f[3] = bf_hi(w.y); f[4] = bf_lo(w.z); f[5] = bf_hi(w.z); f[6] = bf_lo(w.w); f[7] = bf_hi(w.w); }

template <int W> __device__ __forceinline__ void pool_item(const bf16_t* __restrict__ U, bf16_t* __restrict__ Dp, int row0, int ch) {
    const int tl0 = row0 & (SEQ - 1);
    u32x4 r[W + 7];
#pragma unroll
    for (int j = 0; j < W + 7; ++j) { const int dt = j - (W - 1);
        r[j] = (tl0 + dt >= 0) ? *(const u32x4*)(U + (size_t)(row0 + dt) * PD + ch) : (u32x4){0u, 0u, 0u, 0u}; }
    float s[8] = {0.f, 0.f, 0.f, 0.f, 0.f, 0.f, 0.f, 0.f};
#pragma unroll
    for (int j = 0; j < W - 1; ++j) { float f[8]; unpack8(r[j], f);
#pragma unroll
        for (int e = 0; e < 8; ++e) s[e] += f[e]; }
#pragma unroll
    for (int i = 0; i < 8; ++i) {
        float cur[8]; unpack8(r[W - 1 + i], cur);
#pragma unroll
        for (int e = 0; e < 8; ++e) s[e] += cur[e];
        const int cnt = (tl0 + i + 1 < W) ? (tl0 + i + 1) : W;
        const float inv = 1.0f / (float)cnt;
        f32x4 o0, o1;
#pragma unroll
        for (int e = 0; e < 4; ++e) { o0[e] = s[e] * inv - cur[e]; o1[e] = s[4 + e] * inv - cur[4 + e]; }
        *(u32x4*)(Dp + (size_t)(row0 + i) * PD + ch) = pack8(o0, o1);
        float old[8]; unpack8(r[i], old);
#pragma unroll
        for (int e = 0; e < 8; ++e) s[e] -= old[e];
    }
}

__device__ __forceinline__ void attn_item(const bf16_t* __restrict__ Q, const bf16_t* __restrict__ Kb, const bf16_t* __restrict__ VT, bf16_t* __restrict__ Oa, float sink2, int b, int h, int q0, int lane) {
    const int i = lane & 31, hi = lane >> 5, hk = h >> 2;
    const size_t rowbase = (size_t)b * SEQ;
    const int pi = (i & 19) | ((i & 4) << 1) | ((i & 8) >> 1);
    const int jmin = q0 >= 128 ? 0 : 4 - (q0 >> 5);
    bf16x8 qf[4];
    const bf16_t* qp = Q + (rowbase + q0 + i) * AD + h * 64 + 8 * hi;
#pragma unroll
    for (int s = 0; s < 4; ++s) qf[s] = *(const bf16x8*)(qp + 16 * s);
    bf16x8 kf[5][4];
#pragma unroll
    for (int j = 0; j < 5; ++j) { const int jj = j < jmin ? jmin : j;
        const bf16_t* kp = Kb + (rowbase + q0 - 128 + 32 * jj + pi) * KVD + hk * 64 + 8 * hi;
#pragma unroll
        for (int s = 0; s < 4; ++s) kf[j][s] = *(const bf16x8*)(kp + 16 * s); }
    f32x16 sc[5];
#pragma unroll
    for (int j = 0; j < 5; ++j) { sc[j] = (f32x16){};
#pragma unroll
        for (int s = 0; s < 4; ++s) sc[j] = __builtin_amdgcn_mfma_f32_32x32x16_bf16(kf[j][s], qf[s], sc[j], 0, 0, 0); }
    asm volatile("" ::: "memory");
    bf16x8 vf[5][2][2];
    const bf16_t* vp = VT + ((size_t)(b * 2 + hk) * 64 + i) * SEQ + 8 * hi;
#pragma unroll
    for (int j = 0; j < 5; ++j) { const int jj = j < jmin ? jmin : j; const int kb = q0 - 128 + 32 * jj;
#pragma unroll
        for (int ks = 0; ks < 2; ++ks)
#pragma unroll
            for (int dt = 0; dt < 2; ++dt) vf[j][ks][dt] = *(const bf16x8*)(vp + (size_t)(32 * dt) * SEQ + kb + 16 * ks); }
    const float NEG = -INFINITY;
    float mx = sink2;
#pragma unroll
    for (int j = 0; j < 5; ++j) {
#pragma unroll
        for (int r = 0; r < 16; ++r) { const int kk = 8 * hi + (r & 7) + 16 * (r >> 3);
            bool ok = j >= jmin;
            if (j == 0) ok = ok && (kk >= i + 1);
            if (j == 4) ok = ok && (kk <= i);
            sc[j][r] = ok ? sc[j][r] : NEG;
            mx = fmaxf(mx, sc[j][r]); } }
    mx = fmaxf(mx, __shfl_xor(mx, 32));
    float l = 0.f;
    f32x16 o[2]; o[0] = (f32x16){}; o[1] = (f32x16){};
#pragma unroll
    for (int j = 0; j < 5; ++j) {
#pragma unroll
        for (int r = 0; r < 16; ++r) { sc[j][r] = __builtin_amdgcn_exp2f(sc[j][r] - mx); l += sc[j][r]; }
        u32x4 pw[2];
        pw[0] = (u32x4){cvt_pk_bf16(sc[j][0], sc[j][1]), cvt_pk_bf16(sc[j][2], sc[j][3]), cvt_pk_bf16(sc[j][4], sc[j][5]), cvt_pk_bf16(sc[j][6], sc[j][7])};
        pw[1] = (u32x4){cvt_pk_bf16(sc[j][8], sc[j][9]), cvt_pk_bf16(sc[j][10], sc[j][11]), cvt_pk_bf16(sc[j][12], sc[j][13]), cvt_pk_bf16(sc[j][14], sc[j][15])};
#pragma unroll
        for (int ks = 0; ks < 2; ++ks)
#pragma unroll
            for (int dt = 0; dt < 2; ++dt) o[dt] = __builtin_amdgcn_mfma_f32_32x32x16_bf16(vf[j][ks][dt], __builtin_bit_cast(bf16x8, pw[ks]), o[dt], 0, 0, 0);
        __builtin_amdgcn_sched_barrier(0);
    }
    l += __shfl_xor(l, 32);
    l += __builtin_amdgcn_exp2f(sink2 - mx);
    const float rl = 1.0f / l;
    bf16_t* op = Oa + (rowbase + q0 + i) * AD + h * 64 + 4 * hi;
#pragma unroll
    for (int dt = 0; dt < 2; ++dt)
#pragma unroll
        for (int rq = 0; rq < 4; ++rq) { u32x2 w; w.x = cvt_pk_bf16(o[dt][4 * rq] * rl, o[dt][4 * rq + 1] * rl); w.y = cvt_pk_bf16(o[dt][4 * rq + 2] * rl, o[dt][4 * rq + 3] * rl);
            *(u32x2*)(op + 32 * dt + 8 * rq) = w; }
}

__device__ __forceinline__ void mixer_phase(const Args& a, int l, int gw, int NGW, int lane) {
    asm volatile("" : "+v"(lane));
    unsigned char* ws = a.ws;
    const bf16_t* U = (const bf16_t*)(ws + WS_U); bf16_t* Dp = (bf16_t*)(ws + WS_DP);
    for (int it = gw; it < (M / 32) * 4; it += NGW) {
        const int g = it & 3, chunk = it >> 2;
        const int row0 = chunk * 32 + (lane >> 4) * 8, ch = g * 128 + (lane & 15) * 8;
        if (g == 0) pool_item<2>(U, Dp, row0, ch); else if (g == 1) pool_item<4>(U, Dp, row0, ch); else if (g == 2) pool_item<8>(U, Dp, row0, ch); else pool_item<16>(U, Dp, row0, ch);
    }
    const bf16_t* Q = (const bf16_t*)(ws + WS_Q); const bf16_t* Kb = (const bf16_t*)(ws + WS_K); const bf16_t* VT = (const bf16_t*)(ws + WS_VT); bf16_t* Oa = (bf16_t*)(ws + WS_OA);
    for (int it = gw; it < NB * 8 * (SEQ / 32); it += NGW) {
        const int g = it & 3, qb = (it >> 2) & 255, hk = (it >> 10) & 1, b = it >> 11, h = hk * 4 + g;
        const float sink2 = a.sinks[l * 8 + h] * LOG2E;
        attn_item(Q, Kb, VT, Oa, sink2, b, h, qb * 32, lane);
    }
}


#define XB_TMO      128
#define XB_XCNT(j)  (256  + 64 * (j))
#define XB_XSUB(j)  (1280 + 64 * (j))
#define XB_XGEN(j)  (2304 + 64 * (j))
#define XB_TOP      3328
#define XB_TOPGEN   3392
#define XCD_BAR_WORDS 3456
#define XB_SPIN_CAP (1u << 22)
__device__ __forceinline__ unsigned xb_ld(unsigned* p)              { return __hip_atomic_load(p, __ATOMIC_RELAXED, __HIP_MEMORY_SCOPE_AGENT); }
__device__ __forceinline__ unsigned xb_add(unsigned* p, unsigned v) { return __hip_atomic_fetch_add(p, v, __ATOMIC_RELAXED, __HIP_MEMORY_SCOPE_AGENT); }
__device__ __forceinline__ unsigned xb_xcc_id() { return (unsigned)__builtin_amdgcn_s_getreg((3 << 11) | 20) & 0xFu; }
#define XB_SPIN(cond, bar) do { unsigned _sp = 0; while (cond) { __builtin_amdgcn_s_sleep(1); \
    if ((++_sp & 255u) == 0u) { if (xb_ld(&(bar)[XB_TMO])) break; if (_sp > XB_SPIN_CAP) { atomicAdd(&(bar)[XB_TMO], 1u); break; } } } } while (0)
__device__ __forceinline__ void xcd_barrier_post(unsigned* bar) { if (threadIdx.x == 0) (void)xb_add(&bar[XB_XCNT(xb_xcc_id())], 1u); }
__device__ __forceinline__ void xcd_barrier_complete(unsigned* bar, unsigned x, unsigned& nloc, unsigned& nx) {
    const unsigned G = gridDim.x * gridDim.y * gridDim.z;
    unsigned sum, cnt, mine, sp = 0u;
    for (;;) {
        sum = 0u; cnt = 0u; mine = 0u;
#pragma unroll
        for (unsigned j = 0; j < 16; ++j) { const unsigned c = xb_ld(&bar[XB_XCNT(j)]); sum += c; cnt += (c > 0u) ? 1u : 0u; mine = (j == x) ? c : mine; }
        if (sum == G) break;
        __builtin_amdgcn_s_sleep(1);
        if ((++sp & 255u) == 0u) { if (xb_ld(&bar[XB_TMO])) break; if (sp > XB_SPIN_CAP) { atomicAdd(&bar[XB_TMO], 1u); break; } }
    }
    nloc = mine > 0u ? mine : 1u; nx = cnt > 0u ? cnt : 1u;
}
__device__ __forceinline__ void xcd_barrier(unsigned* bar_in, volatile LAS unsigned* st) {
    asm volatile("s_waitcnt vmcnt(0)" ::: "memory");
    __syncthreads();
    int t0 = threadIdx.x; asm volatile("" : "+v"(t0));
    if (t0 == 0) {
        unsigned* bar = bar_in; asm volatile("" : "+s"(bar));
        const unsigned bx = xb_xcc_id();
        __builtin_amdgcn_s_waitcnt(0);
        unsigned nloc = st[0], nx = st[1];
        if (nloc == 0u) { xcd_barrier_complete(bar, bx, nloc, nx); st[0] = nloc; st[1] = nx; }
        const unsigned old = xb_add(&bar[XB_XSUB(bx)], 1u);
        const unsigned gen = old / nloc;
        if (old + 1u == (gen + 1u) * nloc) {
            __builtin_amdgcn_fence(__ATOMIC_RELEASE, "agent");
            asm volatile("s_waitcnt vmcnt(0)" ::: "memory");
            const unsigned og = xb_add(&bar[XB_TOP], 1u);
            const unsigned tg = og / nx;
            if (og + 1u == (tg + 1u) * nx) xb_add(&bar[XB_TOPGEN], 1u);
            else XB_SPIN(xb_ld(&bar[XB_TOPGEN]) == tg, bar);
            __builtin_amdgcn_fence(__ATOMIC_ACQUIRE, "agent");
            xb_add(&bar[XB_XGEN(bx)], 1u);
            asm volatile("s_waitcnt vmcnt(0)" ::: "memory");
        } else {
            XB_SPIN(xb_ld(&bar[XB_XGEN(bx)]) == gen, bar);
            __builtin_amdgcn_fence(__ATOMIC_ACQUIRE, "agent");
            asm volatile("s_waitcnt vmcnt(0)" ::: "memory");
        }
    }
    __syncthreads();
}

constexpr int LDS_BYTES = 131072 + 8192;
__global__ void __launch_bounds__(512, 2) fwd_kernel(Args a) {
    extern __shared__ __attribute__((aligned(16))) unsigned char lds_raw[];
    LAS unsigned char* lds = (LAS unsigned char*)lds_raw;
    cg::grid_group grid = cg::this_grid();
    grid.sync();
    if (threadIdx.x < 16) ((volatile LAS unsigned*)(lds + 131072))[threadIdx.x] = 0u;
    __syncthreads();
    xcd_barrier_post((unsigned*)a.ws);
#define GRID_SYNC() xcd_barrier((unsigned*)a.ws, (volatile LAS unsigned*)(lds + 131072 + 32))
    const int tid = threadIdx.x, lane = tid & 63, wave = __builtin_amdgcn_readfirstlane(tid >> 6);
    const int G = gridDim.x, gw = blockIdx.x * 8 + wave, NGW = G * 8;
    unsigned char* ws = a.ws;
    float* ss = (float*)(ws + WS_SS);
    bf16_t* XB = (bf16_t*)(ws + WS_XB); bf16_t* H = (bf16_t*)(ws + WS_BIG);
    bf16_t* Mb = (bf16_t*)(ws + WS_U);

    prologue(a, lds, gw, NGW, lane, wave);
    GRID_SYNC();

#pragma unroll 1
    for (int l = 0; l < DEPTH; ++l) {
        const unsigned char* wl = ws + WS_W + (size_t)l * LW_BYTES;
        pg8::StaticOrder S;
        {
            pg8::Gemm g{XB, (const bf16_t*)(wl + LW_GU1), M, NGU, DM}; S.init(M, NGU, G, (int)blockIdx.x);
            EpiGU E{H, ss};
            pg8::gemm_phase<EpiGU, true>(lds, g, S, E);
        }
        GRID_SYNC();
        {
            pg8::Gemm g{H, (const bf16_t*)(wl + LW_D1), M, DM, FF}; S.init(M, DM, G, (int)blockIdx.x);
            EpiResid E{XB, nullptr, ss, 0.5f};
            pg8::gemm_phase<EpiResid, true, true>(lds, g, S, E);
        }
        GRID_SYNC();
        {
            pg8::Gemm g{XB, (const bf16_t*)(wl + LW_IN), M, NIN, DM}; S.init(M, NIN, G, (int)blockIdx.x);
            EpiWin E{ss, (bf16_t*)(ws + WS_U), (bf16_t*)(ws + WS_Q), (bf16_t*)(ws + WS_K), (bf16_t*)(ws + WS_VT), (bf16_t*)(ws + WS_G),
                     a.qn + l * 64, a.kn + l * 64, (const float*)(ws + WS_ROPE)};
            pg8::gemm_phase<EpiWin, true>(lds, g, S, E);
        }
        GRID_SYNC();
        mixer_phase(a, l, gw, NGW, lane);
        GRID_SYNC();
        {
            S.init(M, DM, G, (int)blockIdx.x);
            pg8::Gemm g1{(const bf16_t*)(ws + WS_DP), (const bf16_t*)(wl + LW_PB), M, DM, PD};
            EpiBranch<false> E1{Mb, (const bf16_t*)(ws + WS_G)};
            pg8::gemm_phase<EpiBranch<false>, true>(lds, g1, S, E1);
            pg8::Gemm g2{(const bf16_t*)(ws + WS_OA), (const bf16_t*)(wl + LW_AB), M, DM, AD};
            EpiBranch<true> E2{Mb, (const bf16_t*)(ws + WS_G)};
            pg8::gemm_phase<EpiBranch<true>, true>(lds, g2, S, E2);
        }
        GRID_SYNC();
        {
            pg8::Gemm g{Mb, (const bf16_t*)(wl + LW_OUT), M, DM, DM}; S.init(M, DM, G, (int)blockIdx.x);
            EpiResid E{XB, nullptr, ss, 1.0f};
            pg8::gemm_phase<EpiResid, true>(lds, g, S, E);
        }
        GRID_SYNC();
        {
            pg8::Gemm g{XB, (const bf16_t*)(wl + LW_GU2), M, NGU, DM}; S.init(M, NGU, G, (int)blockIdx.x);
            EpiGU E{H, ss};
            pg8::gemm_phase<EpiGU, true>(lds, g, S, E);
        }
        GRID_SYNC();
        {
            pg8::Gemm g{H, (const bf16_t*)(wl + LW_D2), M, DM, FF}; S.init(M, DM, G, (int)blockIdx.x);
            EpiResid E{XB, l < DEPTH - 1 ? nullptr : a.out, l < DEPTH - 1 ? ss : nullptr, 0.5f};
            pg8::gemm_phase<EpiResid, true, true>(lds, g, S, E);
        }
        if (l < DEPTH - 1) GRID_SYNC();
    }
}

extern "C" void kernel_launch(void* const* d_in, const int* in_sizes, int n_in, void* d_out, int out_size, void* d_ws, size_t ws_size, hipStream_t stream) {
    static int grid = 0;
    if (grid == 0) {
        if (n_in != 17 || in_sizes[0] != M * DM || out_size != M * DM || ws_size < WS_END) { fprintf(stderr, "kernel_launch: unexpected shapes (n_in %d, in0 %d, out %d, ws %zu)\n", n_in, n_in > 0 ? in_sizes[0] : -1, out_size, ws_size); grid = -1; return; }
        int dev = 0, cus = 0, per_cu = 0;
        if (hipGetDevice(&dev) != hipSuccess || hipDeviceGetAttribute(&cus, hipDeviceAttributeMultiprocessorCount, dev) != hipSuccess) { grid = -1; return; }
        if (hipFuncSetAttribute((const void*)fwd_kernel, hipFuncAttributeMaxDynamicSharedMemorySize, LDS_BYTES) != hipSuccess) { fprintf(stderr, "kernel_launch: hipFuncSetAttribute failed\n"); grid = -1; return; }
        if (hipOccupancyMaxActiveBlocksPerMultiprocessor(&per_cu, (const void*)fwd_kernel, 512, LDS_BYTES) != hipSuccess || per_cu < 1) per_cu = 1;
        (void)hipGetLastError();
        grid = cus * per_cu;
    }
    if (grid < 0) return;
    Args a{};
    a.x = (const float*)d_in[0]; a.ln1 = (const float*)d_in[1]; a.wgu1 = (const float*)d_in[2]; a.wd1 = (const float*)d_in[3]; a.lnm = (const float*)d_in[4];
    a.win = (const float*)d_in[5]; a.poolw = (const float*)d_in[6]; a.pscale = (const float*)d_in[7]; a.wpb = (const float*)d_in[8]; a.qn = (const float*)d_in[9];
    a.kn = (const float*)d_in[10]; a.sinks = (const float*)d_in[11]; a.wab = (const float*)d_in[12]; a.wout = (const float*)d_in[13]; a.ln2 = (const float*)d_in[14];
    a.wgu2 = (const float*)d_in[15]; a.wd2 = (const float*)d_in[16];
    a.out = (float*)d_out; a.ws = (unsigned char*)d_ws;
    void* args[] = {&a};
    if (hipMemsetAsync(d_ws, 0, 16384, stream) != hipSuccess) { fprintf(stderr, "kernel_launch: hipMemsetAsync failed\n"); return; }
    const hipError_t e = hipLaunchCooperativeKernel((const void*)fwd_kernel, dim3(grid), dim3(512), args, LDS_BYTES, stream);
    if (e != hipSuccess) fprintf(stderr, "kernel_launch: cooperative launch failed: %s (grid %d)\n", hipGetErrorString(e), grid);
}
```

```cpp
#include <hip/hip_runtime.h>
#include <hip/hip_cooperative_groups.h>
#include <cstdio>
#include <cstdint>
namespace cg = cooperative_groups;

namespace pg8 {
#define PG8_LAS __attribute__((address_space(3)))
typedef unsigned short bf16_t;
typedef short bf16x8 __attribute__((ext_vector_type(8)));
typedef float f32x4 __attribute__((ext_vector_type(4)));
typedef unsigned u32x4 __attribute__((ext_vector_type(4)));
typedef unsigned u32x2 __attribute__((ext_vector_type(2)));
constexpr int BM = 256, BK = 64, HALF = 128, HTB = HALF * BK * 2, STAGE_BYTES = 8 * HTB, NXCD = 8, WGM = 8;

__host__ __device__ __forceinline__ int lds_byte(int r, int c) { const int st = (r >> 4) * 2 + (c >> 5), rr = r & 15, cc = c & 31, ob = rr * 64 + cc * 2; return st * 1024 + (ob ^ (((ob >> 9) & 1) << 5)); }
__host__ __device__ __forceinline__ void stage_rc(int b, int& R, int& C) { const int st = b / 1024, sb = b % 1024, swz = sb ^ (((sb >> 9) & 1) << 5); R = (st >> 1) * 16 + swz / 64; C = (st & 1) * 32 + (swz % 64) / 2; }
__host__ __device__ __forceinline__ int perm32(int rho) { const int n = rho >> 4, i = rho & 15; return 8 * (i >> 2) + 4 * n + (i & 3); }

struct Unit { int pm, pn, part; };
struct Gemm { const bf16_t* A; const bf16_t* Bt; int M, N, K; size_t a_pad; const bf16_t* A2; const bf16_t* Bt2; };

struct StaticOrder {
    int nM, nN, nwg, G, c, dual, rev, half;
    __host__ __device__ void init(int M, int N, int G_, int c_, int dual_ = 0, int rev_ = 0, int half_ = -1) { nM = M / BM; nN = N / BM; nwg = nM * nN; G = G_; c = c_; dual = dual_; rev = rev_; half = half_; }
    __host__ __device__ bool next(int i, Unit& u) const {
        u.part = dual ? (i & 1) : 0;
        int it = dual ? (i >> 1) : i; const int nsteps = (nwg - c + G - 1) / G; if (it >= nsteps) return false; if (rev) it = nsteps - 1 - it;
        const long L = (long)it * G + c; if (L >= nwg) return false;
        int wgid = (int)L; { const int q = nwg / NXCD, r = nwg % NXCD, xcd = wgid % NXCD, off = wgid / NXCD; wgid = (xcd < r ? xcd * (q + 1) : r * (q + 1) + (xcd - r) * q) + off; }
        const int nig = WGM * nN, gid = wgid / nig, fm = gid * WGM, gsz = (nM - fm) < WGM ? (nM - fm) : WGM;
        u.pm = fm + ((wgid % nig) % gsz); u.pn = (wgid % nig) / gsz;
        if (half >= 0) u.pm = u.pm + ((u.pm >> 4) << 4) + 16 * half;
        return true;
    }
};

__device__ __forceinline__ unsigned cvt_pk_bf16(float lo, float hi) { unsigned r; asm volatile("v_cvt_pk_bf16_f32 %0, %1, %2" : "=v"(r) : "v"(lo), "v"(hi)); return r; }

template <class Epi, bool ALIGN_EPI, bool ABLK = false>
__device__ __forceinline__ void gemm_phase(PG8_LAS unsigned char* lds, const Gemm g, const StaticOrder& S, const Epi& E) {
    int tid = threadIdx.x; asm volatile("" : "+v"(tid));
    const int wid = __builtin_amdgcn_readfirstlane(tid >> 6), lane = tid & 63, wr = wid >> 2, wc = wid & 3, fr = lane & 15, fq = lane >> 4;
    const int K = g.K, nt = K / BK;
    unsigned voffA[2], voffB[2];
#pragma unroll
    for (int i = 0; i < 2; ++i) { int R, C; stage_rc(tid * 16 + i * 8192, R, C); const int Rb = (R & ~31) + perm32(R & 31);
        voffA[i] = (unsigned)(R * (ABLK ? BK : K) + C) * 2u; voffB[i] = (unsigned)(Rb * K + C) * 2u; }
    const size_t kstep = (size_t)(BK * 2);
    const size_t hstep = (size_t)HALF * K * 2;
    const size_t tstep = 2 * hstep;
    const size_t kstepA = ABLK ? (size_t)(BM * BK * 2) : kstep, hstepA = ABLK ? (size_t)(HALF * BK * 2) : hstep;
    const unsigned ldsw = (unsigned)wid * 1024u;
    const int aoff = lds_byte(wr * 64 + fr, fq * 8), boff = lds_byte(wc * 32 + fr, fq * 8);
#define PG8_SA(b, h) (((b) * 2 + (h)) * HTB)
#define PG8_SB(b, h) ((4 + (b) * 2 + (h)) * HTB)
#define PG8_STAGE(bufoff, gbase, voff) do { _Pragma("unroll") for (int _i = 0; _i < 2; ++_i) \
        __builtin_amdgcn_global_load_lds((const unsigned*)((const char*)(gbase) + (voff)[_i]), (PG8_LAS unsigned*)(lds + (bufoff) + ldsw + _i * 8192), 16, 0, 0); } while (0)
#define PG8_LDA(dst, b, h) do { _Pragma("unroll") for (int m = 0; m < 4; ++m) _Pragma("unroll") for (int k = 0; k < 2; ++k) dst[m][k] = *(const PG8_LAS bf16x8*)(lds + PG8_SA(b, h) + aoff + m * 2048 + k * 1024); } while (0)
#define PG8_LDB(dst, b, h) do { _Pragma("unroll") for (int n = 0; n < 2; ++n) _Pragma("unroll") for (int k = 0; k < 2; ++k) dst[n][k] = *(const PG8_LAS bf16x8*)(lds + PG8_SB(b, h) + boff + n * 2048 + k * 1024); } while (0)
#define PG8_MMA(ai, bj, At, Bt) do { __builtin_amdgcn_s_setprio(1); _Pragma("unroll") for (int m = 0; m < 4; ++m) _Pragma("unroll") for (int n = 0; n < 2; ++n) _Pragma("unroll") for (int k = 0; k < 2; ++k) \
        acc[ai][bj][m][n] = __builtin_amdgcn_mfma_f32_16x16x32_bf16(Bt[n][k], At[m][k], acc[ai][bj][m][n], 0, 0, 0); __builtin_amdgcn_s_setprio(0); } while (0)
#define PG8_WAIT_V(n) asm volatile("s_waitcnt vmcnt(" #n ")" ::: "memory")
#define PG8_WAIT_L(n) asm volatile("s_waitcnt lgkmcnt(" #n ")" ::: "memory")
#define PG8_BAR __builtin_amdgcn_s_barrier()
#define PG8_SCHED __builtin_amdgcn_sched_barrier(0)
    Unit cur, nxt; int ui = 0;
    if (!S.next(0, cur)) return;
    f32x4 acc[2][2][4][2];
#pragma unroll
    for (int a = 0; a < 2; ++a)
#pragma unroll
        for (int b = 0; b < 2; ++b)
#pragma unroll
            for (int m = 0; m < 4; ++m)
#pragma unroll
                for (int n = 0; n < 2; ++n) acc[a][b][m][n] = (f32x4){0.f, 0.f, 0.f, 0.f};
    bf16x8 At[4][2], B0[2][2], B1[2][2];
    typedef float f32x2 __attribute__((ext_vector_type(2)));
    f32x2 rsp = (f32x2){0.f, 0.f};
    PG8_LAS float* rsbuf = (PG8_LAS float*)(lds + STAGE_BYTES + 1024);
    const char* cA = (const char*)(Epi::DUAL && cur.part ? g.A2 : g.A) + (size_t)cur.pm * tstep + (size_t)(cur.pm >> 5) * g.a_pad; const char* cB = (const char*)(Epi::DUAL && cur.part ? g.Bt2 : g.Bt) + (size_t)cur.pn * tstep;
    PG8_STAGE(PG8_SB(0, 0), cB, voffB); PG8_STAGE(PG8_SB(0, 1), cB + hstep, voffB); PG8_STAGE(PG8_SA(0, 0), cA, voffA); PG8_STAGE(PG8_SA(0, 1), cA + hstepA, voffA);
    if (wr == 1) PG8_BAR;
    PG8_WAIT_V(2); PG8_BAR;
    PG8_STAGE(PG8_SB(1, 0), cB + kstep, voffB); PG8_STAGE(PG8_SA(1, 0), cA + kstepA, voffA); PG8_STAGE(PG8_SB(1, 1), cB + hstep + kstep, voffB);
    PG8_WAIT_V(6); PG8_BAR;
    for (;;) {
        const bool has_next = S.next(ui + 1, nxt);
        const char* nA = has_next ? (const char*)(Epi::DUAL && nxt.part ? g.A2 : g.A) + (size_t)nxt.pm * tstep + (size_t)(nxt.pm >> 5) * g.a_pad : cA; const char* nB = has_next ? (const char*)(Epi::DUAL && nxt.part ? g.Bt2 : g.Bt) + (size_t)nxt.pn * tstep : cB;
        for (int t = 0; t < nt; t += 2) {
            const bool last = (t == nt - 2);
            const char* a1 = cA + (size_t)(t + 1) * kstepA;
            const char* a2 = last ? nA : cA + (size_t)(t + 2) * kstepA; const char* b2 = last ? nB : cB + (size_t)(t + 2) * kstep;
            const char* a3 = a2 + kstepA; const char* b3 = b2 + kstep;
            if constexpr (Epi::NEEDS_RS) { if (last) rsp = *(const f32x2*)(E.ss + ((size_t)(cur.pm * BM + (tid >> 1)) * 4 + (tid & 1) * 2)); }
            PG8_LDB(B0, 0, 0); PG8_LDB(B1, 0, 1); PG8_SCHED; PG8_LDA(At, 0, 0); PG8_STAGE(PG8_SA(1, 1), a1 + hstepA, voffA);
            PG8_WAIT_V(8); PG8_WAIT_L(0); PG8_BAR; PG8_MMA(0, 0, At, B0); PG8_MMA(0, 1, At, B1); PG8_BAR; PG8_SCHED;
            PG8_LDA(At, 0, 1); PG8_STAGE(PG8_SB(0, 0), b2, voffB); PG8_STAGE(PG8_SB(0, 1), b2 + hstep, voffB); PG8_STAGE(PG8_SA(0, 0), a2, voffA);
            PG8_WAIT_V(8); PG8_WAIT_L(0); PG8_BAR; PG8_MMA(1, 0, At, B0); PG8_MMA(1, 1, At, B1); PG8_BAR; PG8_SCHED;
            PG8_LDB(B0, 1, 0); PG8_LDB(B1, 1, 1); PG8_SCHED; PG8_LDA(At, 1, 0); PG8_STAGE(PG8_SA(0, 1), a2 + hstepA, voffA);
            PG8_WAIT_V(8); PG8_WAIT_L(0); PG8_BAR; PG8_MMA(0, 0, At, B0); PG8_MMA(0, 1, At, B1); PG8_BAR; PG8_SCHED;
            PG8_LDA(At, 1, 1); PG8_STAGE(PG8_SB(1, 0), b3, voffB); PG8_STAGE(PG8_SB(1, 1), b3 + hstep, voffB); PG8_STAGE(PG8_SA(1, 0), a3, voffA);
            PG8_WAIT_V(8); PG8_WAIT_L(0); PG8_BAR; PG8_MMA(1, 0, At, B0); PG8_MMA(1, 1, At, B1); PG8_BAR; PG8_SCHED;
        }
        if constexpr (ALIGN_EPI) { if (wr == 0) PG8_BAR; }
        if constexpr (Epi::NEEDS_RS) {
            float sq = rsp[0] + rsp[1];
            sq += __shfl_xor(sq, 1);
            if ((tid & 1) == 0) rsbuf[tid >> 1] = __builtin_amdgcn_rsqf(sq * (1.f / 1024.f) + 1e-6f);
            PG8_WAIT_L(0); PG8_BAR; asm volatile("" ::: "memory");
        }
        bool keep = false;
        if constexpr (Epi::DUAL) { if (cur.part == 0) { E.mid(acc, cur, wr, wc, fr, fq); keep = true; } else E(acc, cur, wr, wc, fr, fq, rsbuf); }
        else E(acc, cur, wr, wc, fr, fq, rsbuf);
        if (!has_next) break;
        if (!keep)
#pragma unroll
        for (int a = 0; a < 2; ++a)
#pragma unroll
            for (int b = 0; b < 2; ++b)
#pragma unroll
                for (int m = 0; m < 4; ++m)
#pragma unroll
                    for (int n = 0; n < 2; ++n) acc[a][b][m][n] = (f32x4){0.f, 0.f, 0.f, 0.f};
        cur = nxt; cA = nA; cB = nB; ++ui;
        if constexpr (ALIGN_EPI) { if (wr == 1) PG8_BAR; }
    }
    PG8_WAIT_V(0);
    if constexpr (!ALIGN_EPI) { if (wr == 0) PG8_BAR; }
    PG8_BAR;
#undef PG8_SA
#undef PG8_SB
#undef PG8_STAGE
#undef PG8_LDA
#undef PG8_LDB
#undef PG8_MMA
#undef PG8_WAIT_V
#undef PG8_WAIT_L
#undef PG8_BAR
#undef PG8_SCHED
}
}

using pg8::bf16_t; using pg8::bf16x8; using pg8::f32x4; using pg8::u32x4; using pg8::u32x2; using pg8::Unit; using pg8::cvt_pk_bf16;
typedef float f32x16 __attribute__((ext_vector_type(16)));
#define LAS __attribute__((address_space(3)))

constexpr int DM = 1024, NB = 8, SEQ = 8192, DEPTH = 4, M = NB * SEQ;
constexpr int FF = 2816, NGU = 2 * FF, NIN = 3328, PD = 512, AD = 512, KVD = 128;
constexpr float EPSN = 1e-6f, LOG2E = 1.4426950408889634f;
constexpr float QSCALE = 0.125f * LOG2E;

constexpr size_t MiB = 1u << 20;
constexpr size_t WS_ROPE = 1 * MiB;
constexpr size_t WS_SS = 2 * MiB;
constexpr size_t WS_W = 8 * MiB;
constexpr size_t LW_GU1 = 0, LW_D1 = 11 * MiB, LW_IN = LW_D1 + 11 * MiB / 2, LW_PB = LW_IN + 13 * MiB / 2, LW_AB = LW_PB + 1 * MiB,
                 LW_OUT = LW_AB + 1 * MiB, LW_GU2 = LW_OUT + 2 * MiB, LW_D2 = LW_GU2 + 11 * MiB, LW_BYTES = LW_D2 + 11 * MiB / 2;
static_assert(LW_BYTES == 87 * MiB / 2, "weights per layer");
constexpr size_t WS_XB = 184 * MiB;
constexpr size_t WS_DP = 312 * MiB;
constexpr size_t WS_OA = 376 * MiB;
constexpr size_t WS_BIG = 440 * MiB;
constexpr size_t ARENA = 52 * MiB, AR_U = 0, AR_Q = 8 * MiB, AR_K = 16 * MiB, AR_VT = 18 * MiB, AR_G = 20 * MiB, WS_END = WS_BIG + 8 * ARENA;
constexpr size_t ARE = ARENA / 2;
static_assert(WS_W + 4 * LW_BYTES <= WS_XB && (size_t)SEQ * FF * 2 <= ARENA && AR_G + (size_t)SEQ * 2048 * 2 <= ARENA && WS_END <= 1024 * MiB, "d_ws map");

__device__ __forceinline__ float bf_lo(unsigned w) { return __uint_as_float(w << 16); }
__device__ __forceinline__ float bf_hi(unsigned w) { return __uint_as_float(w & 0xffff0000u); }
__device__ __forceinline__ u32x4 pack8(const f32x4 a, const f32x4 b) { u32x4 w; w.x = cvt_pk_bf16(a[0], a[1]); w.y = cvt_pk_bf16(a[2], a[3]); w.z = cvt_pk_bf16(b[0], b[1]); w.w = cvt_pk_bf16(b[2], b[3]); return w; }

__device__ __forceinline__ float smul_after(float a, float b, float dep) { float r; asm("v_mul_f32_e32 %0, %1, %2" : "=v"(r) : "v"(a), "v"(b), "v"(dep)); return r; }
#define SMUL(a, b) smul_after((a), (b), rs)
struct EpiGU {
    static constexpr bool DUAL = false;
    static constexpr bool NEEDS_RS = true;
    bf16_t* H; const float* ss;
    __device__ __forceinline__ void operator()(const f32x4 (&acc)[2][2][4][2], const Unit& u, int wr, int wc, int fr, int fq, const PG8_LAS float* rsbuf) const {
        bf16_t* hb = H + (size_t)(u.pm >> 5) * ARE + ((size_t)((u.pm & 31) * (FF / 64) + 2 * u.pn + (wc >> 1)) * 256 + wr * 64 + fr) * 64 + (wc & 1) * 32 + 8 * fq;
#pragma unroll
        for (int ai = 0; ai < 2; ++ai)
#pragma unroll
            for (int m = 0; m < 4; ++m) {
                const float rs = rsbuf[ai * 128 + wr * 64 + m * 16 + fr];
                const float c1 = -LOG2E * rs, rs2 = rs * rs;
                f32x4 h[2];
#pragma unroll
                for (int n = 0; n < 2; ++n) { const f32x4 ag = acc[ai][0][m][n], au = acc[ai][1][m][n];
#pragma unroll
                    for (int k = 0; k < 4; ++k) { const float e = __builtin_amdgcn_exp2f(SMUL(ag[k], c1)); const float r = __builtin_amdgcn_rcpf(e + 1.0f);
                        h[n][k] = SMUL(SMUL(ag[k], au[k]), rs2) * r; } }
                *(u32x4*)(hb + (ai * 128 + m * 16) * 64) = pack8(h[0], h[1]);
            }
    }
};

struct EpiResid {
    static constexpr bool DUAL = false;
    static constexpr bool NEEDS_RS = false;
    bf16_t* xb; float* outf; float* ss_out; float scale;
    __device__ __forceinline__ void operator()(const f32x4 (&acc)[2][2][4][2], const Unit& u, int wr, int wc, int fr, int fq, const PG8_LAS float* rsbuf) const {
        const int row0 = u.pm * 256 + wr * 64 + fr, col0 = u.pn * 256 + wc * 32 + 8 * fq;
        PG8_LAS float* sqbuf = (PG8_LAS float*)(rsbuf + 256);
#pragma unroll
        for (int ai = 0; ai < 2; ++ai) {
            u32x4 xw[4][2];
#pragma unroll
            for (int m = 0; m < 4; ++m)
#pragma unroll
                for (int bj = 0; bj < 2; ++bj) xw[m][bj] = *(const u32x4*)(xb + (size_t)(row0 + ai * 128 + m * 16) * DM + col0 + bj * 128);
            asm volatile("" ::: "memory");
#pragma unroll
            for (int m = 0; m < 4; ++m) {
                const int row = row0 + ai * 128 + m * 16; float sq = 0.f;
#pragma unroll
                for (int bj = 0; bj < 2; ++bj) { const size_t off = (size_t)row * DM + col0 + bj * 128;
                    const u32x4 x4 = xw[m][bj];
                    const f32x4 v0 = (f32x4){bf_lo(x4.x), bf_hi(x4.x), bf_lo(x4.y), bf_hi(x4.y)} + acc[ai][bj][m][0] * scale;
                    const f32x4 v1 = (f32x4){bf_lo(x4.z), bf_hi(x4.z), bf_lo(x4.w), bf_hi(x4.w)} + acc[ai][bj][m][1] * scale;
                    if (outf) { *(f32x4*)(outf + off) = v0; *(f32x4*)(outf + off + 4) = v1; }
                    else { const u32x4 w = pack8(v0, v1); *(u32x4*)(xb + off) = w;
                        const f32x4 r0 = (f32x4){bf_lo(w.x), bf_hi(w.x), bf_lo(w.y), bf_hi(w.y)}, r1 = (f32x4){bf_lo(w.z), bf_hi(w.z), bf_lo(w.w), bf_hi(w.w)};
                        sq += (r0[0] * r0[0] + r0[1] * r0[1]) + (r0[2] * r0[2] + r0[3] * r0[3]) + (r1[0] * r1[0] + r1[1] * r1[1]) + (r1[2] * r1[2] + r1[3] * r1[3]); } }
                if (ss_out) { sq += __shfl_xor(sq, 16); sq += __shfl_xor(sq, 32);
                    if (fq == 0) sqbuf[(ai * 128 + wr * 64 + m * 16 + fr) * 4 + wc] = sq; }
            }
            asm volatile("" ::: "memory");
        }
        if (ss_out) {
            asm volatile("s_waitcnt lgkmcnt(0)" ::: "memory"); __builtin_amdgcn_s_barrier(); asm volatile("" ::: "memory");
            const int t = (wr * 4 + wc) * 64 + fq * 16 + fr;
            if (t < 256) { const f32x4 p = *(const PG8_LAS f32x4*)(sqbuf + t * 4); ss_out[(size_t)(u.pm * 256 + t) * 4 + u.pn] = (p[0] + p[1]) + (p[2] + p[3]); }
        }
    }
};

struct EpiWin {
    static constexpr bool DUAL = false;
    static constexpr bool NEEDS_RS = true;
    const float* ss; bf16_t* big; const float *qn, *kn, *rope;
    __device__ __forceinline__ void operator()(const f32x4 (&acc)[2][2][4][2], const Unit& u, int wr, int wc, int fr, int fq, const PG8_LAS float* rsbuf) const {
        const int row0 = (u.pm & 31) * 256 + wr * 64 + fr, pn = u.pn;
        bf16_t* const ar = big + (size_t)(u.pm >> 5) * ARE;
        bf16_t* const U = ar + AR_U / 2; bf16_t* const Q = ar + AR_Q / 2; bf16_t* const Kb = ar + AR_K / 2; bf16_t* const VT = ar + AR_VT / 2; bf16_t* const G = ar + AR_G / 2;
        if (pn < 2) {
            bf16_t* dst = U + pn * 256 + wc * 32 + 8 * fq;
#pragma unroll
            for (int ai = 0; ai < 2; ++ai)
#pragma unroll
                for (int m = 0; m < 4; ++m) {
                    const int row = row0 + ai * 128 + m * 16;
                    const float rs = rsbuf[ai * 128 + wr * 64 + m * 16 + fr];
#pragma unroll
                    for (int bj = 0; bj < 2; ++bj) *(u32x4*)(dst + (size_t)row * 512 + bj * 128) = pack8(acc[ai][bj][m][0] * rs, acc[ai][bj][m][1] * rs);
                }
        } else if (pn >= 5) {
            bf16_t* dst = G + (pn - 5) * 128 + wc * 32 + 8 * fq;
#pragma unroll
            for (int ai = 0; ai < 2; ++ai)
#pragma unroll
                for (int m = 0; m < 4; ++m) {
                    const int row = row0 + ai * 128 + m * 16;
                    const float c1 = -LOG2E * rsbuf[ai * 128 + wr * 64 + m * 16 + fr];
                    f32x4 rr[2], ga[2];
#pragma unroll
                    for (int n = 0; n < 2; ++n) { const f32x4 tp = acc[ai][0][m][n] * c1, ta = acc[ai][1][m][n] * c1; f32x4 dp, da;
#pragma unroll
                        for (int e = 0; e < 4; ++e) { dp[e] = 1.f + __builtin_amdgcn_exp2f(fminf(tp[e], 60.f)); da[e] = 1.f + __builtin_amdgcn_exp2f(fminf(ta[e], 60.f)); }
#pragma unroll
                        for (int e = 0; e < 4; ++e) { rr[n][e] = da[e] * __builtin_amdgcn_rcpf(dp[e]); ga[n][e] = __builtin_amdgcn_rcpf(da[e]); } }
                    *(u32x4*)(dst + (size_t)row * 2048) = pack8(rr[0], rr[1]);
                    *(u32x4*)(dst + (size_t)row * 2048 + 1024) = pack8(ga[0], ga[1]);
                }
        } else if (pn < 4 || wc < 2) {
            const bool isq = pn < 4;
            const float* gain = isq ? qn : kn;
            const f32x4 g00 = *(const f32x4*)(gain + (fq < 2 ? 4 * fq : 8 * fq)), g01 = *(const f32x4*)(gain + (fq < 2 ? 4 * fq + 8 : 8 * fq + 4));
            const f32x4 g10 = *(const f32x4*)(gain + 32 + 8 * fq), g11 = *(const f32x4*)(gain + 36 + 8 * fq);
            const float osc = isq ? QSCALE : 1.f;
            bf16_t* dst = isq ? Q + (4 * (pn - 2) + wc) * 64 : Kb + wc * 64; const int ld = isq ? AD : KVD;
            dst += 8 * fq;
#pragma unroll
            for (int ai = 0; ai < 2; ++ai)
#pragma unroll
                for (int m = 0; m < 4; ++m) {
                    const int row = row0 + ai * 128 + m * 16;
                    const float rs = rsbuf[ai * 128 + wr * 64 + m * 16 + fr];
                    f32x4 a = acc[ai][0][m][0] * rs, b = acc[ai][0][m][1] * rs, c = acc[ai][1][m][0] * rs, d = acc[ai][1][m][1] * rs;
                    float sq = (a[0] * a[0] + a[1] * a[1]) + (a[2] * a[2] + a[3] * a[3]) + (b[0] * b[0] + b[1] * b[1]) + (b[2] * b[2] + b[3] * b[3])
                             + (c[0] * c[0] + c[1] * c[1]) + (c[2] * c[2] + c[3] * c[3]) + (d[0] * d[0] + d[1] * d[1]) + (d[2] * d[2] + d[3] * d[3]);
                    sq += __shfl_xor(sq, 16); sq += __shfl_xor(sq, 32);
                    const float rq = __builtin_amdgcn_rsqf(sq * (1.f / 64.f) + EPSN);
                    a = a * rq * g00; b = b * rq * g01; c = c * (rq * osc) * g10; d = d * (rq * osc) * g11;
                    const int t = row & (SEQ - 1);
                    const f32x4 cs = *(const f32x4*)(rope + t * 16 + 4 * (fq & 1)), sn = *(const f32x4*)(rope + t * 16 + 8 + 4 * (fq & 1));
                    const f32x4 ra = a * cs - b * sn, rb = b * cs + a * sn;
                    if (fq < 2) { a = ra; b = rb; }
                    a = a * osc; b = b * osc;
                    *(u32x4*)(dst + (size_t)row * ld) = pack8(a, b);
                    *(u32x4*)(dst + (size_t)row * ld + 32) = pack8(c, d);
                    if (m & 1) asm volatile("" ::: "memory");
                }
        } else {
            const int hv = wc - 2;
#pragma unroll
            for (int ai = 0; ai < 2; ++ai)
#pragma unroll
                for (int m = 0; m < 4; ++m) {
                    const int row = row0 + ai * 128 + m * 16;
                    const float rs = rsbuf[ai * 128 + wr * 64 + m * 16 + fr];
                    bf16_t* vb = VT + ((size_t)(hv * 64 + 8 * fq)) * SEQ + row;
#pragma unroll
                    for (int bj = 0; bj < 2; ++bj)
#pragma unroll
                        for (int n = 0; n < 2; ++n) { const f32x4 v = acc[ai][bj][m][n] * rs;
                            const unsigned w0 = cvt_pk_bf16(v[0], v[1]), w1 = cvt_pk_bf16(v[2], v[3]);
                            bf16_t* p = vb + (size_t)(32 * bj + 4 * n) * SEQ;
                            p[0] = (bf16_t)(w0 & 0xffffu); p[SEQ] = (bf16_t)(w0 >> 16); p[2 * SEQ] = (bf16_t)(w1 & 0xffffu); p[3 * SEQ] = (bf16_t)(w1 >> 16); }
                }
        }
    }
};

struct EpiBranch {
    static constexpr bool DUAL = true;
    static constexpr bool NEEDS_RS = false;
    bf16_t* big;
    template <bool END> __device__ __forceinline__ void run(f32x4 (&acc)[2][2][4][2], const Unit& u, int wr, int wc, int fr, int fq) const {
        const int row0 = (u.pm & 31) * 256 + wr * 64 + fr, col0 = u.pn * 256 + wc * 32 + 8 * fq;
        bf16_t* const Mb = big + (size_t)(u.pm >> 5) * ARE + AR_U / 2; const bf16_t* const G = big + (size_t)(u.pm >> 5) * ARE + AR_G / 2 + (END ? 1024 : 0);
#pragma unroll
        for (int ai = 0; ai < 2; ++ai) {
            u32x4 gw[4][2];
#pragma unroll
            for (int m = 0; m < 4; ++m)
#pragma unroll
                for (int bj = 0; bj < 2; ++bj) gw[m][bj] = *(const u32x4*)(G + (size_t)(row0 + ai * 128 + m * 16) * 2048 + col0 + bj * 128);
            asm volatile("" ::: "memory");
#pragma unroll
            for (int m = 0; m < 4; ++m)
#pragma unroll
                for (int bj = 0; bj < 2; ++bj) { const u32x4 g4 = gw[m][bj];
                    const f32x4 v0 = acc[ai][bj][m][0] * (f32x4){bf_lo(g4.x), bf_hi(g4.x), bf_lo(g4.y), bf_hi(g4.y)};
                    const f32x4 v1 = acc[ai][bj][m][1] * (f32x4){bf_lo(g4.z), bf_hi(g4.z), bf_lo(g4.w), bf_hi(g4.w)};
                    if (END) *(u32x4*)(Mb + (size_t)(row0 + ai * 128 + m * 16) * DM + col0 + bj * 128) = pack8(v0, v1);
                    else { acc[ai][bj][m][0] = v0; acc[ai][bj][m][1] = v1; } }
            asm volatile("" ::: "memory");
        }
    }
    __device__ __forceinline__ void mid(f32x4 (&acc)[2][2][4][2], const Unit& u, int wr, int wc, int fr, int fq) const { run<false>(acc, u, wr, wc, fr, fq); }
    __device__ __forceinline__ void operator()(f32x4 (&acc)[2][2][4][2], const Unit& u, int wr, int wc, int fr, int fq, const PG8_LAS float* rsbuf) const { run<true>(acc, u, wr, wc, fr, fq); }
};

__device__ __forceinline__ int sigma_inv4(int d4) { return d4 < 16 ? 8 * ((d4 >> 2) & 1) + 4 * (d4 >> 3) : d4; }
template <int MODE> __device__ __forceinline__ int src_group(int n0, bool& perm) {
    perm = false;
    if (MODE == 0) return n0;
    if (MODE == 1) { const int tile = n0 >> 8, loc = n0 & 255; return loc < 128 ? tile * 128 + loc : FF + tile * 128 + (loc - 128); }
    if (n0 < 512) return n0;
    if (n0 >= 1280) { const int j = (n0 >> 8) - 5, loc = n0 & 255; return 1280 + ((loc >> 7) ? 1024 : 0) + 128 * j + (loc & 127); }
    const int pn = n0 >> 8, loc = n0 & 255, bj = loc >> 7, wc = (loc & 127) >> 5;
    if (pn < 4) { perm = (bj == 0); return 512 + (4 * (pn - 2) + wc) * 64 + 32 * bj; }
    if (wc < 2) { perm = (bj == 0); return 1024 + 64 * wc + 32 * bj; }
    return 1152 + 64 * (wc - 2) + 32 * bj;
}
struct TItem { const float* W; const float* gain; bf16_t* WT; int K, N, mode, r; };
__device__ __forceinline__ int src_group_rt(int mode, int n0, bool& perm) { if (mode == 1) return src_group<1>(n0, perm); if (mode == 2) return src_group<2>(n0, perm); return src_group<0>(n0, perm); }
__device__ __forceinline__ void titem_load(const TItem& t, int lane, f32x4 (&v)[8], int& jd) {
    const int nblk = t.N / 32, kb = t.r / nblk, nb = t.r % nblk, k0 = 64 * kb, n0 = 32 * nb;
    bool perm; const int src = src_group_rt(t.mode, n0, perm);
    const int c4 = 4 * (lane & 7); jd = perm ? sigma_inv4(c4) : c4;
#pragma unroll
    for (int i = 0; i < 8; ++i) { const int kk = 8 * i + (lane >> 3);
        v[i] = *(const f32x4*)(t.W + (size_t)(k0 + kk) * t.N + src + c4);
        if (t.gain) v[i] = v[i] * t.gain[k0 + kk]; }
}
__device__ __forceinline__ void titem_store(const TItem& t, LAS float* scr, int lane, const f32x4 (&v)[8], int jd) {
    const int nblk = t.N / 32, kb = t.r / nblk, nb = t.r % nblk, k0 = 64 * kb, n0 = 32 * nb;
#pragma unroll
    for (int i = 0; i < 8; ++i) { const int kk = 8 * i + (lane >> 3); LAS float* s = scr + kk * 33 + jd; s[0] = v[i][0]; s[1] = v[i][1]; s[2] = v[i][2]; s[3] = v[i][3]; }
    asm volatile("s_waitcnt lgkmcnt(0)" ::: "memory");
    const int c = lane & 7;
#pragma unroll
    for (int j = 0; j < 4; ++j) { const int n = (lane >> 3) + 8 * j; const LAS float* s = scr + (8 * c) * 33 + n;
        u32x4 o; o.x = cvt_pk_bf16(s[0 * 33], s[1 * 33]); o.y = cvt_pk_bf16(s[2 * 33], s[3 * 33]); o.z = cvt_pk_bf16(s[4 * 33], s[5 * 33]); o.w = cvt_pk_bf16(s[6 * 33], s[7 * 33]);
        *(u32x4*)(t.WT + (size_t)(n0 + n) * t.K + k0 + 8 * c) = o; }
    asm volatile("s_waitcnt lgkmcnt(0)" ::: "memory");
}

struct Args {
    const float *x, *ln1, *wgu1, *wd1, *lnm, *win, *poolw, *pscale, *wpb, *qn, *kn, *sinks, *wab, *wout, *ln2, *wgu2, *wd2;
    float* out; unsigned char* ws;
};

__device__ __forceinline__ float wave_sum(float v) {
#pragma unroll
    for (int o = 1; o < 64; o <<= 1) v += __shfl_xor(v, o);
    return v;
}

__device__ __forceinline__ void prologue(const Args& a, LAS unsigned char* lds, int gw, int NGW, int lane, int wave) {
    LAS float* scr = (LAS float*)(lds + wave * 16384);
    unsigned char* ws = a.ws;
    constexpr int I_GU = (DM / 64) * (NGU / 32), I_D = (FF / 64) * (DM / 32), I_IN = (DM / 64) * (NIN / 32), I_AB = (AD / 64) * (DM / 32), I_OUT = (DM / 64) * (DM / 32);
    constexpr int I_LAYER = 2 * I_GU + 2 * I_D + I_IN + I_AB + I_OUT;
    auto resolve = [&](int it) {
        TItem t; const int l = it / I_LAYER; int r = it % I_LAYER;
        unsigned char* wl = ws + WS_W + (size_t)l * LW_BYTES;
        if (r < I_GU) { t = TItem{a.wgu1 + (size_t)l * DM * NGU, a.ln1 + l * DM, (bf16_t*)(wl + LW_GU1), DM, NGU, 1, r}; return t; } r -= I_GU;
        if (r < I_GU) { t = TItem{a.wgu2 + (size_t)l * DM * NGU, a.ln2 + l * DM, (bf16_t*)(wl + LW_GU2), DM, NGU, 1, r}; return t; } r -= I_GU;
        if (r < I_D) { t = TItem{a.wd1 + (size_t)l * FF * DM, nullptr, (bf16_t*)(wl + LW_D1), FF, DM, 0, r}; return t; } r -= I_D;
        if (r < I_D) { t = TItem{a.wd2 + (size_t)l * FF * DM, nullptr, (bf16_t*)(wl + LW_D2), FF, DM, 0, r}; return t; } r -= I_D;
        if (r < I_IN) { t = TItem{a.win + (size_t)l * DM * NIN, a.lnm + l * DM, (bf16_t*)(wl + LW_IN), DM, NIN, 2, r}; return t; } r -= I_IN;
        if (r < I_AB) { t = TItem{a.wab + (size_t)l * AD * DM, nullptr, (bf16_t*)(wl + LW_AB), AD, DM, 0, r}; return t; } r -= I_AB;
        t = TItem{a.wout + (size_t)l * DM * DM, nullptr, (bf16_t*)(wl + LW_OUT), DM, DM, 0, r}; return t;
    };
    for (int it = gw; it < DEPTH * I_LAYER; it += 2 * NGW) {
        const bool hasB = it + NGW < DEPTH * I_LAYER;
        const TItem A = resolve(it), B = resolve(hasB ? it + NGW : it);
        f32x4 va[8], vb[8]; int ja, jb;
        titem_load(A, lane, va, ja); titem_load(B, lane, vb, jb);
        titem_store(A, scr, lane, va, ja);
        if (hasB) titem_store(B, scr, lane, vb, jb);
    }
    for (int it = gw; it < DEPTH * 1024; it += NGW) {
        const int l = it >> 10, r = it & 1023, nb = r & 15, co = (r >> 4) & 15, g = r >> 8;
        const int n = nb * 64 + lane, c0 = co * 8;
        const float* pw = a.poolw + ((size_t)(l * 4 + g) * 128 + c0) * 128;
        const float* sc = a.pscale + l * PD + g * 128;
        const float* wp = a.wpb + ((size_t)l * PD + g * 128) * DM + n;
        float s[8] = {0.f, 0.f, 0.f, 0.f, 0.f, 0.f, 0.f, 0.f};
#pragma unroll 16
        for (int d = 0; d < 128; ++d) { const float w = sc[d] * wp[(size_t)d * DM];
#pragma unroll
            for (int i = 0; i < 8; ++i) s[i] += pw[i * 128 + d] * w; }
        u32x4 o; o.x = cvt_pk_bf16(s[0], s[1]); o.y = cvt_pk_bf16(s[2], s[3]); o.z = cvt_pk_bf16(s[4], s[5]); o.w = cvt_pk_bf16(s[6], s[7]);
        *(u32x4*)((bf16_t*)(ws + WS_W + (size_t)l * LW_BYTES + LW_PB) + (size_t)n * PD + g * 128 + c0) = o;
    }
    float* rope = (float*)(ws + WS_ROPE);
    for (int i = gw * 64 + lane; i < SEQ * 8; i += NGW * 64) { const int t = i >> 3, k = i & 7;
        const float inv = powf(500000.0f, -(float)(2 * k) / 16.0f); const float ang = (float)t * inv; float sn, cs; sincosf(ang, &sn, &cs);
        rope[t * 16 + k] = cs; rope[t * 16 + 8 + k] = sn; }
    float* ss = (float*)(ws + WS_SS);
    bf16_t* XB = (bf16_t*)(ws + WS_XB);
    for (int row0 = gw; row0 < M; row0 += 4 * NGW) {
        f32x4 v[4][4];
#pragma unroll
        for (int q = 0; q < 4; ++q) { const int row = row0 + q * NGW; const float* xr = a.x + (size_t)(row < M ? row : row0) * DM + 8 * lane;
#pragma unroll
            for (int j = 0; j < 2; ++j) { v[q][2 * j] = *(const f32x4*)(xr + 512 * j); v[q][2 * j + 1] = *(const f32x4*)(xr + 512 * j + 4); } }
#pragma unroll
        for (int q = 0; q < 4; ++q) { const int row = row0 + q * NGW; if (row >= M) break; float sq = 0.f;
#pragma unroll
            for (int j = 0; j < 2; ++j) { const f32x4 v0 = v[q][2 * j], v1 = v[q][2 * j + 1];
                sq += (v0[0] * v0[0] + v0[1] * v0[1]) + (v0[2] * v0[2] + v0[3] * v0[3]) + (v1[0] * v1[0] + v1[1] * v1[1]) + (v1[2] * v1[2] + v1[3] * v1[3]);
                *(u32x4*)(XB + (size_t)row * DM + 8 * lane + 512 * j) = pack8(v0, v1); }
            sq = wave_sum(sq);
            if (lane < 4) ss[(size_t)row * 4 + lane] = lane == 0 ? sq : 0.f; }
    }
}

__device__ __forceinline__ void unpack8(const u32x4 w, float (&f)[8]) { f[0] = bf_lo(w.x); f[1] = bf_hi(w.x); f[2] = bf_lo(w.y); f[3] = bf_hi(w.y); f[4] = bf_lo(w.z); f[5] = bf_hi(w.z); f[6] = bf_lo(w.w); f[7] = bf_hi(w.w); }

template <int W> __device__ __forceinline__ void pool_item(const bf16_t* __restrict__ U, bf16_t* __restrict__ Dp, int row0, int ch) {
    const int tl0 = row0;
    u32x4 r[W + 7];
#pragma unroll
    for (int j = 0; j < W + 7; ++j) { const int dt = j - (W - 1);
        r[j] = (tl0 + dt >= 0) ? *(const u32x4*)(U + (size_t)(row0 + dt) * PD + ch) : (u32x4){0u, 0u, 0u, 0u}; }
    float s[8] = {0.f, 0.f, 0.f, 0.f, 0.f, 0.f, 0.f, 0.f};
#pragma unroll
    for (int j = 0; j < W - 1; ++j) { float f[8]; unpack8(r[j], f);
#pragma unroll
        for (int e = 0; e < 8; ++e) s[e] += f[e]; }
#pragma unroll
    for (int i = 0; i < 8; ++i) {
        float cur[8]; unpack8(r[W - 1 + i], cur);
#pragma unroll
        for (int e = 0; e < 8; ++e) s[e] += cur[e];
        const int cnt = (tl0 + i + 1 < W) ? (tl0 + i + 1) : W;
        const float inv = 1.0f / (float)cnt;
        f32x4 o0, o1;
#pragma unroll
        for (int e = 0; e < 4; ++e) { o0[e] = s[e] * inv - cur[e]; o1[e] = s[4 + e] * inv - cur[4 + e]; }
        *(u32x4*)(Dp + (size_t)(row0 + i) * PD + ch) = pack8(o0, o1);
        float old[8]; unpack8(r[i], old);
#pragma unroll
        for (int e = 0; e < 8; ++e) s[e] -= old[e];
    }
}

__device__ __forceinline__ void attn_item(const bf16_t* __restrict__ Q, const bf16_t* __restrict__ Kb, const bf16_t* __restrict__ VT, bf16_t* __restrict__ Oa, float sink2, int h, int q0, int lane) {
    const int i = lane & 31, hi = lane >> 5, hk = h >> 2;
    const size_t rowbase = 0;
    const int pi = (i & 19) | ((i & 4) << 1) | ((i & 8) >> 1);
    const int jmin = q0 >= 128 ? 0 : 4 - (q0 >> 5);
    bf16x8 qf[4];
    const bf16_t* qp = Q + (rowbase + q0 + i) * AD + h * 64 + 8 * hi;
#pragma unroll
    for (int s = 0; s < 4; ++s) qf[s] = *(const bf16x8*)(qp + 16 * s);
    bf16x8 kf[5][4];
#pragma unroll
    for (int j = 0; j < 5; ++j) { const int jj = j < jmin ? jmin : j;
        const bf16_t* kp = Kb + (rowbase + q0 - 128 + 32 * jj + pi) * KVD + hk * 64 + 8 * hi;
#pragma unroll
        for (int s = 0; s < 4; ++s) kf[j][s] = *(const bf16x8*)(kp + 16 * s); }
    f32x16 sc[5];
#pragma unroll
    for (int j = 0; j < 5; ++j) { sc[j] = (f32x16){};
#pragma unroll
        for (int s = 0; s < 4; ++s) sc[j] = __builtin_amdgcn_mfma_f32_32x32x16_bf16(kf[j][s], qf[s], sc[j], 0, 0, 0); }
    asm volatile("" ::: "memory");
    bf16x8 vf[5][2][2];
    const bf16_t* vp = VT + ((size_t)(hk * 64 + i)) * SEQ + 8 * hi;
#pragma unroll
    for (int j = 0; j < 5; ++j) { const int jj = j < jmin ? jmin : j; const int kb = q0 - 128 + 32 * jj;
#pragma unroll
        for (int ks = 0; ks < 2; ++ks)
#pragma unroll
            for (int dt = 0; dt < 2; ++dt) vf[j][ks][dt] = *(const bf16x8*)(vp + (size_t)(32 * dt) * SEQ + kb + 16 * ks); }
    const float NEG = -INFINITY;
    float mx = sink2;
#pragma unroll
    for (int j = 0; j < 5; ++j) {
#pragma unroll
        for (int r = 0; r < 16; ++r) { const int kk = 8 * hi + (r & 7) + 16 * (r >> 3);
            bool ok = j >= jmin;
            if (j == 0) ok = ok && (kk >= i + 1);
            if (j == 4) ok = ok && (kk <= i);
            sc[j][r] = ok ? sc[j][r] : NEG;
            mx = fmaxf(mx, sc[j][r]); } }
    mx = fmaxf(mx, __shfl_xor(mx, 32));
    float l = 0.f;
    f32x16 o[2]; o[0] = (f32x16){}; o[1] = (f32x16){};
#pragma unroll
    for (int j = 0; j < 5; ++j) {
#pragma unroll
        for (int r = 0; r < 16; ++r) { sc[j][r] = __builtin_amdgcn_exp2f(sc[j][r] - mx); l += sc[j][r]; }
        u32x4 pw[2];
        pw[0] = (u32x4){cvt_pk_bf16(sc[j][0], sc[j][1]), cvt_pk_bf16(sc[j][2], sc[j][3]), cvt_pk_bf16(sc[j][4], sc[j][5]), cvt_pk_bf16(sc[j][6], sc[j][7])};
        pw[1] = (u32x4){cvt_pk_bf16(sc[j][8], sc[j][9]), cvt_pk_bf16(sc[j][10], sc[j][11]), cvt_pk_bf16(sc[j][12], sc[j][13]), cvt_pk_bf16(sc[j][14], sc[j][15])};
#pragma unroll
        for (int ks = 0; ks < 2; ++ks)
#pragma unroll
            for (int dt = 0; dt < 2; ++dt) o[dt] = __builtin_amdgcn_mfma_f32_32x32x16_bf16(vf[j][ks][dt], __builtin_bit_cast(bf16x8, pw[ks]), o[dt], 0, 0, 0);
        __builtin_amdgcn_sched_barrier(0);
    }
    l += __shfl_xor(l, 32);
    l += __builtin_amdgcn_exp2f(sink2 - mx);
    const float rl = 1.0f / l;
    bf16_t* op = Oa + (rowbase + q0 + i) * AD + h * 64 + 4 * hi;
#pragma unroll
    for (int dt = 0; dt < 2; ++dt)
#pragma unroll
        for (int rq = 0; rq < 4; ++rq) { u32x2 w; w.x = cvt_pk_bf16(o[dt][4 * rq] * rl, o[dt][4 * rq + 1] * rl); w.y = cvt_pk_bf16(o[dt][4 * rq + 2] * rl, o[dt][4 * rq + 3] * rl);
            *(u32x2*)(op + 32 * dt + 8 * rq) = w; }
}

__device__ __forceinline__ void mixer_phase(const Args& a, int l, int vgw, int NGW, int lane) {
    asm volatile("" : "+v"(lane));
    unsigned char* ws = a.ws;
    const int wpb = NGW / NB;
    const int b = vgw / wpb, lw = vgw % wpb;
    const bf16_t* ar = (const bf16_t*)(ws + WS_BIG) + (size_t)b * ARE;
    const bf16_t* U = ar + AR_U / 2; bf16_t* Dp = (bf16_t*)(ws + WS_DP) + (size_t)b * SEQ * PD;
    for (int it = lw + (((SEQ / 32) * 4 - 1 - lw) / wpb) * wpb; it >= 0; it -= wpb) {
        const int g = it & 3, chunk = it >> 2;
        const int row0 = chunk * 32 + (lane >> 4) * 8, ch = g * 128 + (lane & 15) * 8;
        if (g == 0) pool_item<2>(U, Dp, row0, ch); else if (g == 1) pool_item<4>(U, Dp, row0, ch); else if (g == 2) pool_item<8>(U, Dp, row0, ch); else pool_item<16>(U, Dp, row0, ch);
    }
    const bf16_t* Q = ar + AR_Q / 2; const bf16_t* Kb = ar + AR_K / 2; const bf16_t* VT = ar + AR_VT / 2; bf16_t* Oa = (bf16_t*)(ws + WS_OA) + (size_t)b * SEQ * AD;
    for (int it = lw + ((8 * (SEQ / 32) - 1 - lw) / wpb) * wpb; it >= 0; it -= wpb) {
        const int g = it & 3, qb = (it >> 2) & 255, hk = it >> 10, h = hk * 4 + g;
        const float sink2 = a.sinks[l * 8 + h] * LOG2E;
        attn_item(Q, Kb, VT, Oa, sink2, h, qb * 32, lane);
    }
}

#define XB_TMO      128
#define XB_XCNT(j)  (256  + 64 * (j))
#define XB_XSUB(j)  (1280 + 64 * (j))
#define XB_XGEN(j)  (2304 + 64 * (j))
#define XB_TOP      3328
#define XB_TOPGEN   3392
#define XCD_BAR_WORDS 3456
#define XB_SPIN_CAP (1u << 22)
__device__ __forceinline__ unsigned xb_ld(unsigned* p)              { return __hip_atomic_load(p, __ATOMIC_RELAXED, __HIP_MEMORY_SCOPE_AGENT); }
__device__ __forceinline__ unsigned xb_add(unsigned* p, unsigned v) { return __hip_atomic_fetch_add(p, v, __ATOMIC_RELAXED, __HIP_MEMORY_SCOPE_AGENT); }
__device__ __forceinline__ unsigned xb_xcc_id() { return (unsigned)__builtin_amdgcn_s_getreg((3 << 11) | 20) & 0xFu; }
#define XB_SPIN(cond, bar) do { unsigned _sp = 0; while (cond) { __builtin_amdgcn_s_sleep(1); \
    if ((++_sp & 255u) == 0u) { if (xb_ld(&(bar)[XB_TMO])) break; if (_sp > XB_SPIN_CAP) { atomicAdd(&(bar)[XB_TMO], 1u); break; } } } } while (0)
__device__ __forceinline__ void xcd_barrier_complete(unsigned* bar, unsigned x, unsigned& nloc, unsigned& nx, unsigned& uniform8) {
    const unsigned G = gridDim.x * gridDim.y * gridDim.z;
    unsigned sum, cnt, mine, bad, sp = 0u;
    for (;;) {
        sum = 0u; cnt = 0u; mine = 0u; bad = 0u;
#pragma unroll
        for (unsigned j = 0; j < 16; ++j) { const unsigned c = xb_ld(&bar[XB_XCNT(j)]); sum += c; cnt += (c > 0u) ? 1u : 0u; mine = (j == x) ? c : mine; bad |= (j < 8u) ? (c * 8u != G) : (c != 0u); }
        if (sum == G) break;
        __builtin_amdgcn_s_sleep(1);
        if ((++sp & 255u) == 0u) { if (xb_ld(&bar[XB_TMO])) break; if (sp > XB_SPIN_CAP) { atomicAdd(&bar[XB_TMO], 1u); break; } }
    }
    nloc = mine > 0u ? mine : 1u; nx = cnt > 0u ? cnt : 1u; uniform8 = (sum == G && bad == 0u) ? 1u : 0u;
}
__device__ __forceinline__ void xcd_barrier(unsigned* bar_in, volatile LAS unsigned* st, bool local) {
    asm volatile("s_waitcnt vmcnt(0)" ::: "memory");
    __syncthreads();
    int t0 = threadIdx.x; asm volatile("" : "+v"(t0));
    if (t0 == 0) {
        unsigned* bar = bar_in; asm volatile("" : "+s"(bar));
        const unsigned bx = xb_xcc_id();
        __builtin_amdgcn_s_waitcnt(0);
        unsigned nloc = st[0], nx = st[1];
        if (nloc == 0u) { unsigned u8; xcd_barrier_complete(bar, bx, nloc, nx, u8); st[0] = nloc; st[1] = nx; st[2] = u8; }
        const unsigned old = xb_add(&bar[XB_XSUB(bx)], 1u);
        const unsigned gen = old / nloc;
        if (old + 1u == (gen + 1u) * nloc) {
            __builtin_amdgcn_fence(__ATOMIC_RELEASE, "agent");
            asm volatile("s_waitcnt vmcnt(0)" ::: "memory");
            if (!local) {
                const unsigned og = xb_add(&bar[XB_TOP], 1u);
                const unsigned tg = og / nx;
                if (og + 1u == (tg + 1u) * nx) xb_add(&bar[XB_TOPGEN], 1u);
                else XB_SPIN(xb_ld(&bar[XB_TOPGEN]) == tg, bar);
            }
            __builtin_amdgcn_fence(__ATOMIC_ACQUIRE, "agent");
            xb_add(&bar[XB_XGEN(bx)], 1u);
            asm volatile("s_waitcnt vmcnt(0)" ::: "memory");
        } else {
            XB_SPIN(xb_ld(&bar[XB_XGEN(bx)]) == gen, bar);
            __builtin_amdgcn_fence(__ATOMIC_ACQUIRE, "agent");
            asm volatile("s_waitcnt vmcnt(0)" ::: "memory");
        }
    }
    __syncthreads();
}

#ifndef SKEW_TICKS
#define SKEW_TICKS 0
#endif
constexpr int LDS_BYTES = 131072 + 8192;
__global__ void __launch_bounds__(512, 2) fwd_kernel(Args a) {
    extern __shared__ __attribute__((aligned(16))) unsigned char lds_raw[];
    LAS unsigned char* lds = (LAS unsigned char*)lds_raw;
    cg::grid_group grid = cg::this_grid();
    grid.sync();
    volatile LAS unsigned* ctlw = (volatile LAS unsigned*)(lds + 131072);
    if (threadIdx.x < 16) ctlw[threadIdx.x] = 0u;
    __syncthreads();
    if (threadIdx.x == 0) { const unsigned x = xb_xcc_id(); ctlw[12] = xb_add(&((unsigned*)a.ws)[XB_XCNT(x)], 1u); ctlw[13] = x; }
    const int tid = threadIdx.x, lane = tid & 63, wave = __builtin_amdgcn_readfirstlane(tid >> 6);
    const int G = gridDim.x, NGW = G * 8;
    unsigned char* ws = a.ws;
    float* ss = (float*)(ws + WS_SS);
    bf16_t* XB = (bf16_t*)(ws + WS_XB); bf16_t* BIG = (bf16_t*)(ws + WS_BIG);

    prologue(a, lds, blockIdx.x * 8 + wave, NGW, lane, wave);
    xcd_barrier((unsigned*)a.ws, ctlw + 8, false);
    const bool local = (G == 256) && (__builtin_amdgcn_readfirstlane(ctlw[10]) == 1u);
    const int vc = local ? (int)(__builtin_amdgcn_readfirstlane(ctlw[12]) * 8u + __builtin_amdgcn_readfirstlane(ctlw[13])) : (int)blockIdx.x;
    const int vgw = (G == 256) ? ((vc & 7) * 256 + (vc >> 3) * 8 + wave) : (vc * 8 + wave);
#define GRID_SYNC() xcd_barrier((unsigned*)a.ws, ctlw + 8, local)
#if SKEW_TICKS > 0
    if (local) { const unsigned long long t0 = __builtin_amdgcn_s_memrealtime(); const unsigned long long w = (unsigned long long)(vc & 7) * SKEW_TICKS;
        while (__builtin_amdgcn_s_memrealtime() - t0 < w) __builtin_amdgcn_s_sleep(32); }
#endif

#pragma unroll 1
    for (int l = 0; l < DEPTH; ++l) {
        const unsigned char* wl = ws + WS_W + (size_t)l * LW_BYTES;
        pg8::StaticOrder S;
        constexpr size_t PAD_H = ARENA - (size_t)SEQ * FF * 2, PAD_MB = ARENA - (size_t)SEQ * DM * 2;
#pragma unroll 1
        for (int hf = 0; hf < 2; ++hf) {
            {
                pg8::Gemm g{XB, (const bf16_t*)(wl + LW_GU1), M, NGU, DM, 0, nullptr, nullptr}; S.init(M / 2, NGU, G, vc, 0, 0, hf);
                EpiGU E{BIG, ss};
                pg8::gemm_phase<EpiGU, true>(lds, g, S, E);
            }
            GRID_SYNC();
            {
                pg8::Gemm g{BIG, (const bf16_t*)(wl + LW_D1), M, DM, FF, PAD_H, nullptr, nullptr}; S.init(M / 2, DM, G, vc, 0, 1, hf);
                EpiResid E{XB, nullptr, ss, 0.5f};
                pg8::gemm_phase<EpiResid, true, true>(lds, g, S, E);
            }
            GRID_SYNC();
        }
        {
            pg8::Gemm g{XB, (const bf16_t*)(wl + LW_IN), M, NIN, DM, 0, nullptr, nullptr}; S.init(M, NIN, G, vc);
            EpiWin E{ss, BIG, a.qn + l * 64, a.kn + l * 64, (const float*)(ws + WS_ROPE)};
            pg8::gemm_phase<EpiWin, true>(lds, g, S, E);
        }
        GRID_SYNC();
        mixer_phase(a, l, vgw, NGW, lane);
        GRID_SYNC();
        {
            S.init(M, DM, G, vc, 1);
            pg8::Gemm g{(const bf16_t*)(ws + WS_DP), (const bf16_t*)(wl + LW_PB), M, DM, PD, 0, (const bf16_t*)(ws + WS_OA), (const bf16_t*)(wl + LW_AB)};
            EpiBranch E{BIG};
            pg8::gemm_phase<EpiBranch, true>(lds, g, S, E);
        }
        GRID_SYNC();
        {
            pg8::Gemm g{BIG + AR_U / 2, (const bf16_t*)(wl + LW_OUT), M, DM, DM, PAD_MB, nullptr, nullptr}; S.init(M, DM, G, vc, 0, 1);
            EpiResid E{XB, nullptr, ss, 1.0f};
            pg8::gemm_phase<EpiResid, true>(lds, g, S, E);
        }
        GRID_SYNC();
#pragma unroll 1
        for (int hf = 0; hf < 2; ++hf) {
            {
                pg8::Gemm g{XB, (const bf16_t*)(wl + LW_GU2), M, NGU, DM, 0, nullptr, nullptr}; S.init(M / 2, NGU, G, vc, 0, 0, hf);
                EpiGU E{BIG, ss};
                pg8::gemm_phase<EpiGU, true>(lds, g, S, E);
            }
            GRID_SYNC();
            {
                pg8::Gemm g{BIG, (const bf16_t*)(wl + LW_D2), M, DM, FF, PAD_H, nullptr, nullptr}; S.init(M / 2, DM, G, vc, 0, 1, hf);
                EpiResid E{XB, l < DEPTH - 1 ? nullptr : a.out, l < DEPTH - 1 ? ss : nullptr, 0.5f};
                pg8::gemm_phase<EpiResid, true, true>(lds, g, S, E);
            }
            if (l < DEPTH - 1 || hf == 0) GRID_SYNC();
        }
    }
}

extern "C" void kernel_launch(void* const* d_in, const int* in_sizes, int n_in, void* d_out, int out_size, void* d_ws, size_t ws_size, hipStream_t stream) {
    static int grid = 0;
    if (grid == 0) {
        if (n_in != 17 || in_sizes[0] != M * DM || out_size != M * DM || ws_size < WS_END) { fprintf(stderr, "kernel_launch: unexpected shapes (n_in %d, in0 %d, out %d, ws %zu)\n", n_in, n_in > 0 ? in_sizes[0] : -1, out_size, ws_size); grid = -1; return; }
        int dev = 0, cus = 0, per_cu = 0;
        if (hipGetDevice(&dev) != hipSuccess || hipDeviceGetAttribute(&cus, hipDeviceAttributeMultiprocessorCount, dev) != hipSuccess) { grid = -1; return; }
        if (hipFuncSetAttribute((const void*)fwd_kernel, hipFuncAttributeMaxDynamicSharedMemorySize, LDS_BYTES) != hipSuccess) { fprintf(stderr, "kernel_launch: hipFuncSetAttribute failed\n"); grid = -1; return; }
        if (hipOccupancyMaxActiveBlocksPerMultiprocessor(&per_cu, (const void*)fwd_kernel, 512, LDS_BYTES) != hipSuccess || per_cu < 1) per_cu = 1;
        (void)hipGetLastError();
        grid = cus * per_cu;
    }
    if (grid < 0) return;
    Args a{};
    a.x = (const float*)d_in[0]; a.ln1 = (const float*)d_in[1]; a.wgu1 = (const float*)d_in[2]; a.wd1 = (const float*)d_in[3]; a.lnm = (const float*)d_in[4];
    a.win = (const float*)d_in[5]; a.poolw = (const float*)d_in[6]; a.pscale = (const float*)d_in[7]; a.wpb = (const float*)d_in[8]; a.qn = (const float*)d_in[9];
    a.kn = (const float*)d_in[10]; a.sinks = (const float*)d_in[11]; a.wab = (const float*)d_in[12]; a.wout = (const float*)d_in[13]; a.ln2 = (const float*)d_in[14];
    a.wgu2 = (const float*)d_in[15]; a.wd2 = (const float*)d_in[16];
    a.out = (float*)d_out; a.ws = (unsigned char*)d_ws;
    void* args[] = {&a};
    if (hipMemsetAsync(d_ws, 0, 16384, stream) != hipSuccess) { fprintf(stderr, "kernel_launch: hipMemsetAsync failed\n"); return; }
    const hipError_t e = hipLaunchCooperativeKernel((const void*)fwd_kernel, dim3(grid), dim3(512), args, LDS_BYTES, stream);
    if (e != hipSuccess) fprintf(stderr, "kernel_launch: cooperative launch failed: %s (grid %d)\n", hipGetErrorString(e), grid);
}
```

```cpp
#include <hip/hip_runtime.h>
#include <hip/hip_cooperative_groups.h>
#include <cstdio>
#include <cstdint>
namespace cg = cooperative_groups;

namespace pg8 {
#define PG8_LAS __attribute__((address_space(3)))
typedef unsigned short bf16_t;
typedef short bf16x8 __attribute__((ext_vector_type(8)));
typedef float f32x4 __attribute__((ext_vector_type(4)));
typedef unsigned u32x4 __attribute__((ext_vector_type(4)));
typedef unsigned u32x2 __attribute__((ext_vector_type(2)));
constexpr int BM = 256, BK = 64, HALF = 128, HTB = HALF * BK * 2, STAGE_BYTES = 8 * HTB, NXCD = 8, WGM = 4;

__host__ __device__ __forceinline__ int lds_byte(int r, int c) { const int st = (r >> 4) * 2 + (c >> 5), rr = r & 15, cc = c & 31, ob = rr * 64 + cc * 2; return st * 1024 + (ob ^ (((ob >> 9) & 1) << 5)); }
__host__ __device__ __forceinline__ void stage_rc(int b, int& R, int& C) { const int st = b / 1024, sb = b % 1024, swz = sb ^ (((sb >> 9) & 1) << 5); R = (st >> 1) * 16 + swz / 64; C = (st & 1) * 32 + (swz % 64) / 2; }
__host__ __device__ __forceinline__ int perm32(int rho) { const int n = rho >> 4, i = rho & 15; return 8 * (i >> 2) + 4 * n + (i & 3); }

struct Unit { int pm, pn, part; };
struct Gemm { const bf16_t* A; const bf16_t* Bt; int M, N, K; size_t a_pad; const bf16_t* A2; const bf16_t* Bt2; };

struct StaticOrder {
    int nM, nN, nwg, G, c, dual, rev, half;
    __host__ __device__ void init(int M, int N, int G_, int c_, int dual_ = 0, int rev_ = 0, int half_ = -1) { nM = M / BM; nN = N / BM; nwg = nM * nN; G = G_; c = c_; dual = dual_; rev = rev_; half = half_; }
    __host__ __device__ bool next(int i, Unit& u) const {
        u.part = dual ? (i & 1) : 0;
        int it = dual ? (i >> 1) : i; const int nsteps = (nwg - c + G - 1) / G; if (it >= nsteps) return false; if (rev) it = nsteps - 1 - it;
        const long L = (long)it * G + c; if (L >= nwg) return false;
        int wgid = (int)L; { const int q = nwg / NXCD, r = nwg % NXCD, xcd = wgid % NXCD, off = wgid / NXCD; wgid = (xcd < r ? xcd * (q + 1) : r * (q + 1) + (xcd - r) * q) + off; }
        const int nig = WGM * nN, gid = wgid / nig, fm = gid * WGM, gsz = (nM - fm) < WGM ? (nM - fm) : WGM;
        u.pm = fm + ((wgid % nig) % gsz); u.pn = (wgid % nig) / gsz;
        if (half >= 0) u.pm = u.pm + ((u.pm >> 4) << 4) + 16 * half;
        return true;
    }
};

__device__ __forceinline__ unsigned cvt_pk_bf16(float lo, float hi) { unsigned r; asm volatile("v_cvt_pk_bf16_f32 %0, %1, %2" : "=v"(r) : "v"(lo), "v"(hi)); return r; }

template <class Epi, bool ALIGN_EPI, bool ABLK = false>
__device__ __forceinline__ void gemm_phase(PG8_LAS unsigned char* lds, const Gemm g, const StaticOrder& S, const Epi& E) {
    int tid = threadIdx.x; asm volatile("" : "+v"(tid));
    const int wid = __builtin_amdgcn_readfirstlane(tid >> 6), lane = tid & 63, wr = wid >> 2, wc = wid & 3, fr = lane & 15, fq = lane >> 4;
    const int K = g.K, nt = K / BK;
    unsigned voffA[2], voffB[2];
#pragma unroll
    for (int i = 0; i < 2; ++i) { int R, C; stage_rc(tid * 16 + i * 8192, R, C); const int Rb = (R & ~31) + perm32(R & 31);
        voffA[i] = (unsigned)(R * (ABLK ? BK : K) + C) * 2u; voffB[i] = (unsigned)(Rb * K + C) * 2u; }
    const size_t kstep = (size_t)(BK * 2);
    const size_t hstep = (size_t)HALF * K * 2;
    const size_t tstep = 2 * hstep;
    const size_t kstepA = ABLK ? (size_t)(BM * BK * 2) : kstep, hstepA = ABLK ? (size_t)(HALF * BK * 2) : hstep;
    const unsigned ldsw = (unsigned)wid * 1024u;
    const int aoff = lds_byte(wr * 64 + fr, fq * 8), boff = lds_byte(wc * 32 + fr, fq * 8);
#define PG8_SA(b, h) (((b) * 2 + (h)) * HTB)
#define PG8_SB(b, h) ((4 + (b) * 2 + (h)) * HTB)
#define PG8_STAGE(bufoff, gbase, voff) do { _Pragma("unroll") for (int _i = 0; _i < 2; ++_i) \
        __builtin_amdgcn_global_load_lds((const unsigned*)((const char*)(gbase) + (voff)[_i]), (PG8_LAS unsigned*)(lds + (bufoff) + ldsw + _i * 8192), 16, 0, 0); } while (0)
#define PG8_LDA(dst, b, h) do { _Pragma("unroll") for (int m = 0; m < 4; ++m) _Pragma("unroll") for (int k = 0; k < 2; ++k) dst[m][k] = *(const PG8_LAS bf16x8*)(lds + PG8_SA(b, h) + aoff + m * 2048 + k * 1024); } while (0)
#define PG8_LDB(dst, b, h) do { _Pragma("unroll") for (int n = 0; n < 2; ++n) _Pragma("unroll") for (int k = 0; k < 2; ++k) dst[n][k] = *(const PG8_LAS bf16x8*)(lds + PG8_SB(b, h) + boff + n * 2048 + k * 1024); } while (0)
#define PG8_MMA(ai, bj, At, Bt) do { __builtin_amdgcn_s_setprio(1); _Pragma("unroll") for (int m = 0; m < 4; ++m) _Pragma("unroll") for (int n = 0; n < 2; ++n) _Pragma("unroll") for (int k = 0; k < 2; ++k) \
        acc[ai][bj][m][n] = __builtin_amdgcn_mfma_f32_16x16x32_bf16(Bt[n][k], At[m][k], acc[ai][bj][m][n], 0, 0, 0); __builtin_amdgcn_s_setprio(0); } while (0)
#define PG8_WAIT_V(n) asm volatile("s_waitcnt vmcnt(" #n ")" ::: "memory")
#define PG8_WAIT_L(n) asm volatile("s_waitcnt lgkmcnt(" #n ")" ::: "memory")
#define PG8_BAR __builtin_amdgcn_s_barrier()
#define PG8_SCHED __builtin_amdgcn_sched_barrier(0)
    Unit cur, nxt; int ui = 0;
    if (!S.next(0, cur)) return;
    f32x4 acc[2][2][4][2];
#pragma unroll
    for (int a = 0; a < 2; ++a)
#pragma unroll
        for (int b = 0; b < 2; ++b)
#pragma unroll
            for (int m = 0; m < 4; ++m)
#pragma unroll
                for (int n = 0; n < 2; ++n) acc[a][b][m][n] = (f32x4){0.f, 0.f, 0.f, 0.f};
    bf16x8 At[4][2], B0[2][2], B1[2][2];
    typedef float f32x2 __attribute__((ext_vector_type(2)));
    f32x2 rsp = (f32x2){0.f, 0.f};
    PG8_LAS float* rsbuf = (PG8_LAS float*)(lds + STAGE_BYTES + 1024);
    const char* cA = (const char*)(Epi::DUAL && cur.part ? g.A2 : g.A) + (size_t)cur.pm * tstep + (size_t)(cur.pm >> 5) * g.a_pad; const char* cB = (const char*)(Epi::DUAL && cur.part ? g.Bt2 : g.Bt) + (size_t)cur.pn * tstep;
    PG8_STAGE(PG8_SB(0, 0), cB, voffB); PG8_STAGE(PG8_SB(0, 1), cB + hstep, voffB); PG8_STAGE(PG8_SA(0, 0), cA, voffA); PG8_STAGE(PG8_SA(0, 1), cA + hstepA, voffA);
    if (wr == 1) PG8_BAR;
    PG8_WAIT_V(2); PG8_BAR;
    PG8_STAGE(PG8_SB(1, 0), cB + kstep, voffB); PG8_STAGE(PG8_SA(1, 0), cA + kstepA, voffA); PG8_STAGE(PG8_SB(1, 1), cB + hstep + kstep, voffB);
    PG8_WAIT_V(6); PG8_BAR;
    for (;;) {
        const bool has_next = S.next(ui + 1, nxt);
        const char* nA = has_next ? (const char*)(Epi::DUAL && nxt.part ? g.A2 : g.A) + (size_t)nxt.pm * tstep + (size_t)(nxt.pm >> 5) * g.a_pad : cA; const char* nB = has_next ? (const char*)(Epi::DUAL && nxt.part ? g.Bt2 : g.Bt) + (size_t)nxt.pn * tstep : cB;
        for (int t = 0; t < nt; t += 2) {
            const bool last = (t == nt - 2);
            const char* a1 = cA + (size_t)(t + 1) * kstepA;
            const char* a2 = last ? nA : cA + (size_t)(t + 2) * kstepA; const char* b2 = last ? nB : cB + (size_t)(t + 2) * kstep;
            const char* a3 = a2 + kstepA; const char* b3 = b2 + kstep;
            if constexpr (Epi::NEEDS_RS) { if (last) rsp = *(const f32x2*)(E.ss + ((size_t)(cur.pm * BM + (tid >> 1)) * 4 + (tid & 1) * 2)); }
            PG8_LDB(B0, 0, 0); PG8_LDB(B1, 0, 1); PG8_SCHED; PG8_LDA(At, 0, 0); PG8_STAGE(PG8_SA(1, 1), a1 + hstepA, voffA);
            PG8_WAIT_V(8); PG8_WAIT_L(0); PG8_BAR; PG8_MMA(0, 0, At, B0); PG8_MMA(0, 1, At, B1); PG8_BAR; PG8_SCHED;
            PG8_LDA(At, 0, 1); PG8_STAGE(PG8_SB(0, 0), b2, voffB); PG8_STAGE(PG8_SB(0, 1), b2 + hstep, voffB); PG8_STAGE(PG8_SA(0, 0), a2, voffA);
            PG8_WAIT_V(8); PG8_WAIT_L(0); PG8_BAR; PG8_MMA(1, 0, At, B0); PG8_MMA(1, 1, At, B1); PG8_BAR; PG8_SCHED;
            PG8_LDB(B0, 1, 0); PG8_LDB(B1, 1, 1); PG8_SCHED; PG8_LDA(At, 1, 0); PG8_STAGE(PG8_SA(0, 1), a2 + hstepA, voffA);
            PG8_WAIT_V(8); PG8_WAIT_L(0); PG8_BAR; PG8_MMA(0, 0, At, B0); PG8_MMA(0, 1, At, B1); PG8_BAR; PG8_SCHED;
            PG8_LDA(At, 1, 1); PG8_STAGE(PG8_SB(1, 0), b3, voffB); PG8_STAGE(PG8_SB(1, 1), b3 + hstep, voffB); PG8_STAGE(PG8_SA(1, 0), a3, voffA);
            PG8_WAIT_V(8); PG8_WAIT_L(0); PG8_BAR; PG8_MMA(1, 0, At, B0); PG8_MMA(1, 1, At, B1); PG8_BAR; PG8_SCHED;
        }
        if constexpr (ALIGN_EPI) { if (wr == 0) PG8_BAR; }
        if constexpr (Epi::NEEDS_RS) {
            float sq = rsp[0] + rsp[1];
            sq += __shfl_xor(sq, 1);
            if ((tid & 1) == 0) rsbuf[tid >> 1] = __builtin_amdgcn_rsqf(sq * (1.f / 1024.f) + 1e-6f);
            PG8_WAIT_L(0); PG8_BAR; asm volatile("" ::: "memory");
        }
        bool keep = false;
        if constexpr (Epi::DUAL) { if (cur.part == 0) { E.mid(acc, cur, wr, wc, fr, fq); keep = true; } else E(acc, cur, wr, wc, fr, fq, rsbuf); }
        else E(acc, cur, wr, wc, fr, fq, rsbuf);
        if (!has_next) break;
        if (!keep)
#pragma unroll
        for (int a = 0; a < 2; ++a)
#pragma unroll
            for (int b = 0; b < 2; ++b)
#pragma unroll
                for (int m = 0; m < 4; ++m)
#pragma unroll
                    for (int n = 0; n < 2; ++n) acc[a][b][m][n] = (f32x4){0.f, 0.f, 0.f, 0.f};
        cur = nxt; cA = nA; cB = nB; ++ui;
        if constexpr (ALIGN_EPI) { if (wr == 1) PG8_BAR; }
    }
    PG8_WAIT_V(0);
    if constexpr (!ALIGN_EPI) { if (wr == 0) PG8_BAR; }
    PG8_BAR;
#undef PG8_SA
#undef PG8_SB
#undef PG8_STAGE
#undef PG8_LDA
#undef PG8_LDB
#undef PG8_MMA
#undef PG8_WAIT_V
#undef PG8_WAIT_L
#undef PG8_BAR
#undef PG8_SCHED
}
}

using pg8::bf16_t; using pg8::bf16x8; using pg8::f32x4; using pg8::u32x4; using pg8::u32x2; using pg8::Unit; using pg8::cvt_pk_bf16;
typedef float f32x16 __attribute__((ext_vector_type(16)));
#define LAS __attribute__((address_space(3)))

constexpr int DM = 1024, NB = 8, SEQ = 8192, DEPTH = 4, M = NB * SEQ;
constexpr int FF = 2816, NGU = 2 * FF, NIN = 3328, PD = 512, AD = 512, KVD = 128;
constexpr float EPSN = 1e-6f, LOG2E = 1.4426950408889634f;
constexpr float QSCALE = 0.125f * LOG2E;

constexpr size_t MiB = 1u << 20;
constexpr size_t WS_ROPE = 1 * MiB;
constexpr size_t WS_SS = 2 * MiB;
constexpr size_t WS_W = 8 * MiB;
constexpr size_t LW_GU1 = 0, LW_D1 = 11 * MiB, LW_IN = LW_D1 + 11 * MiB / 2, LW_PB = LW_IN + 13 * MiB / 2, LW_AB = LW_PB + 1 * MiB,
                 LW_OUT = LW_AB + 1 * MiB, LW_GU2 = LW_OUT + 2 * MiB, LW_D2 = LW_GU2 + 11 * MiB, LW_BYTES = LW_D2 + 11 * MiB / 2;
static_assert(LW_BYTES == 87 * MiB / 2, "weights per layer");
constexpr size_t WS_XB = 184 * MiB;
constexpr size_t WS_DP = 312 * MiB;
constexpr size_t WS_OA = 376 * MiB;
constexpr size_t WS_BIG = 440 * MiB;
constexpr size_t ARENA = 52 * MiB, AR_U = 0, AR_Q = 8 * MiB, AR_K = 16 * MiB, AR_VT = 18 * MiB, AR_G = 20 * MiB, WS_END = WS_BIG + 8 * ARENA;
constexpr size_t ARE = ARENA / 2;
static_assert(WS_W + 4 * LW_BYTES <= WS_XB && (size_t)SEQ * FF * 2 <= ARENA && AR_G + (size_t)SEQ * 2048 * 2 <= ARENA && WS_END <= 1024 * MiB, "d_ws map");

__device__ __forceinline__ float bf_lo(unsigned w) { return __uint_as_float(w << 16); }
__device__ __forceinline__ float bf_hi(unsigned w) { return __uint_as_float(w & 0xffff0000u); }
__device__ __forceinline__ u32x4 pack8(const f32x4 a, const f32x4 b) { u32x4 w; w.x = cvt_pk_bf16(a[0], a[1]); w.y = cvt_pk_bf16(a[2], a[3]); w.z = cvt_pk_bf16(b[0], b[1]); w.w = cvt_pk_bf16(b[2], b[3]); return w; }

struct EpiGU {
    static constexpr bool DUAL = false;
    static constexpr bool NEEDS_RS = true;
    bf16_t* H; const float* ss;
    __device__ __forceinline__ void operator()(const f32x4 (&acc)[2][2][4][2], const Unit& u, int wr, int wc, int fr, int fq, const PG8_LAS float* rsbuf) const {
        bf16_t* hb = H + (size_t)(u.pm >> 5) * ARE + ((size_t)((u.pm & 31) * (FF / 64) + 2 * u.pn + (wc >> 1)) * 256 + wr * 64 + fr) * 64 + (wc & 1) * 32 + 8 * fq;
#pragma unroll
        for (int ai = 0; ai < 2; ++ai)
#pragma unroll
            for (int m = 0; m < 4; ++m) {
                const float rs = rsbuf[ai * 128 + wr * 64 + m * 16 + fr];
                const float c1 = -LOG2E * rs, rs2 = rs * rs;
                f32x4 h[2];
#pragma unroll
                for (int n = 0; n < 2; ++n) { const f32x4 ag = acc[ai][0][m][n], au = acc[ai][1][m][n];
                    const f32x4 t = ag * c1; f32x4 e;
#pragma unroll
                    for (int k = 0; k < 4; ++k) e[k] = __builtin_amdgcn_exp2f(t[k]);
                    const f32x4 d = e + 1.0f; f32x4 r;
#pragma unroll
                    for (int k = 0; k < 4; ++k) r[k] = __builtin_amdgcn_rcpf(d[k]);
                    h[n] = ((ag * au) * rs2) * r; }
                *(u32x4*)(hb + (ai * 128 + m * 16) * 64) = pack8(h[0], h[1]);
            }
    }
};

struct EpiResid {
    static constexpr bool DUAL = false;
    static constexpr bool NEEDS_RS = false;
    bf16_t* xb; float* outf; float* ss_out; float scale;
    __device__ __forceinline__ void operator()(const f32x4 (&acc)[2][2][4][2], const Unit& u, int wr, int wc, int fr, int fq, const PG8_LAS float* rsbuf) const {
        const int row0 = u.pm * 256 + wr * 64 + fr, col0 = u.pn * 256 + wc * 32 + 8 * fq;
        PG8_LAS float* sqbuf = (PG8_LAS float*)(rsbuf + 256);
#pragma unroll
        for (int ai = 0; ai < 2; ++ai) {
            u32x4 xw[4][2];
#pragma unroll
            for (int m = 0; m < 4; ++m)
#pragma unroll
                for (int bj = 0; bj < 2; ++bj) xw[m][bj] = *(const u32x4*)(xb + (size_t)(row0 + ai * 128 + m * 16) * DM + col0 + bj * 128);
            asm volatile("" ::: "memory");
#pragma unroll
            for (int m = 0; m < 4; ++m) {
                const int row = row0 + ai * 128 + m * 16; float sq = 0.f;
#pragma unroll
                for (int bj = 0; bj < 2; ++bj) { const size_t off = (size_t)row * DM + col0 + bj * 128;
                    const u32x4 x4 = xw[m][bj];
                    const f32x4 v0 = (f32x4){bf_lo(x4.x), bf_hi(x4.x), bf_lo(x4.y), bf_hi(x4.y)} + acc[ai][bj][m][0] * scale;
                    const f32x4 v1 = (f32x4){bf_lo(x4.z), bf_hi(x4.z), bf_lo(x4.w), bf_hi(x4.w)} + acc[ai][bj][m][1] * scale;
                    if (outf) { *(f32x4*)(outf + off) = v0; *(f32x4*)(outf + off + 4) = v1; }
                    else { const u32x4 w = pack8(v0, v1); *(u32x4*)(xb + off) = w;
                        const f32x4 r0 = (f32x4){bf_lo(w.x), bf_hi(w.x), bf_lo(w.y), bf_hi(w.y)}, r1 = (f32x4){bf_lo(w.z), bf_hi(w.z), bf_lo(w.w), bf_hi(w.w)};
                        sq += (r0[0] * r0[0] + r0[1] * r0[1]) + (r0[2] * r0[2] + r0[3] * r0[3]) + (r1[0] * r1[0] + r1[1] * r1[1]) + (r1[2] * r1[2] + r1[3] * r1[3]); } }
                if (ss_out) { sq += __shfl_xor(sq, 16); sq += __shfl_xor(sq, 32);
                    if (fq == 0) sqbuf[(ai * 128 + wr * 64 + m * 16 + fr) * 4 + wc] = sq; }
            }
            asm volatile("" ::: "memory");
        }
        if (ss_out) {
            asm volatile("s_waitcnt lgkmcnt(0)" ::: "memory"); __builtin_amdgcn_s_barrier(); asm volatile("" ::: "memory");
            const int t = (wr * 4 + wc) * 64 + fq * 16 + fr;
            if (t < 256) { const f32x4 p = *(const PG8_LAS f32x4*)(sqbuf + t * 4); ss_out[(size_t)(u.pm * 256 + t) * 4 + u.pn] = (p[0] + p[1]) + (p[2] + p[3]); }
        }
    }
};

struct EpiWin {
    static constexpr bool DUAL = false;
    static constexpr bool NEEDS_RS = true;
    const float* ss; bf16_t* big; const float *qn, *kn, *rope;
    __device__ __forceinline__ void operator()(const f32x4 (&acc)[2][2][4][2], const Unit& u, int wr, int wc, int fr, int fq, const PG8_LAS float* rsbuf) const {
        const int row0 = (u.pm & 31) * 256 + wr * 64 + fr, pn = u.pn;
        bf16_t* const ar = big + (size_t)(u.pm >> 5) * ARE;
        bf16_t* const U = ar + AR_U / 2; bf16_t* const Q = ar + AR_Q / 2; bf16_t* const Kb = ar + AR_K / 2; bf16_t* const VT = ar + AR_VT / 2; bf16_t* const G = ar + AR_G / 2;
        if (pn < 2) {
            bf16_t* dst = U + pn * 256 + wc * 32 + 8 * fq;
#pragma unroll
            for (int ai = 0; ai < 2; ++ai)
#pragma unroll
                for (int m = 0; m < 4; ++m) {
                    const int row = row0 + ai * 128 + m * 16;
                    const float rs = rsbuf[ai * 128 + wr * 64 + m * 16 + fr];
#pragma unroll
                    for (int bj = 0; bj < 2; ++bj) *(u32x4*)(dst + (size_t)row * 512 + bj * 128) = pack8(acc[ai][bj][m][0] * rs, acc[ai][bj][m][1] * rs);
                }
        } else if (pn >= 5) {
            bf16_t* dst = G + (pn - 5) * 128 + wc * 32 + 8 * fq;
#pragma unroll
            for (int ai = 0; ai < 2; ++ai)
#pragma unroll
                for (int m = 0; m < 4; ++m) {
                    const int row = row0 + ai * 128 + m * 16;
                    const float c1 = -LOG2E * rsbuf[ai * 128 + wr * 64 + m * 16 + fr];
                    f32x4 rr[2], ga[2];
#pragma unroll
                    for (int n = 0; n < 2; ++n) { const f32x4 tp = acc[ai][0][m][n] * c1, ta = acc[ai][1][m][n] * c1; f32x4 dp, da;
#pragma unroll
                        for (int e = 0; e < 4; ++e) { dp[e] = 1.f + __builtin_amdgcn_exp2f(fminf(tp[e], 60.f)); da[e] = 1.f + __builtin_amdgcn_exp2f(fminf(ta[e], 60.f)); }
#pragma unroll
                        for (int e = 0; e < 4; ++e) { rr[n][e] = da[e] * __builtin_amdgcn_rcpf(dp[e]); ga[n][e] = __builtin_amdgcn_rcpf(da[e]); } }
                    *(u32x4*)(dst + (size_t)row * 2048) = pack8(rr[0], rr[1]);
                    *(u32x4*)(dst + (size_t)row * 2048 + 1024) = pack8(ga[0], ga[1]);
                }
        } else if (pn < 4 || wc < 2) {
            const bool isq = pn < 4;
            const float* gain = isq ? qn : kn;
            const f32x4 g00 = *(const f32x4*)(gain + (fq < 2 ? 4 * fq : 8 * fq)), g01 = *(const f32x4*)(gain + (fq < 2 ? 4 * fq + 8 : 8 * fq + 4));
            const f32x4 g10 = *(const f32x4*)(gain + 32 + 8 * fq), g11 = *(const f32x4*)(gain + 36 + 8 * fq);
            const float osc = isq ? QSCALE : 1.f;
            bf16_t* dst = isq ? Q + (4 * (pn - 2) + wc) * 64 : Kb + wc * 64; const int ld = isq ? AD : KVD;
            dst += 8 * fq;
#pragma unroll
            for (int ai = 0; ai < 2; ++ai)
#pragma unroll
                for (int m = 0; m < 4; ++m) {
                    const int row = row0 + ai * 128 + m * 16;
                    const float rs = rsbuf[ai * 128 + wr * 64 + m * 16 + fr];
                    f32x4 a = acc[ai][0][m][0] * rs, b = acc[ai][0][m][1] * rs, c = acc[ai][1][m][0] * rs, d = acc[ai][1][m][1] * rs;
                    float sq = (a[0] * a[0] + a[1] * a[1]) + (a[2] * a[2] + a[3] * a[3]) + (b[0] * b[0] + b[1] * b[1]) + (b[2] * b[2] + b[3] * b[3])
                             + (c[0] * c[0] + c[1] * c[1]) + (c[2] * c[2] + c[3] * c[3]) + (d[0] * d[0] + d[1] * d[1]) + (d[2] * d[2] + d[3] * d[3]);
                    sq += __shfl_xor(sq, 16); sq += __shfl_xor(sq, 32);
                    const float rq = __builtin_amdgcn_rsqf(sq * (1.f / 64.f) + EPSN);
                    a = a * rq * g00; b = b * rq * g01; c = c * (rq * osc) * g10; d = d * (rq * osc) * g11;
                    const int t = row & (SEQ - 1);
                    const f32x4 cs = *(const f32x4*)(rope + t * 16 + 4 * (fq & 1)), sn = *(const f32x4*)(rope + t * 16 + 8 + 4 * (fq & 1));
                    const f32x4 ra = a * cs - b * sn, rb = b * cs + a * sn;
                    if (fq < 2) { a = ra; b = rb; }
                    a = a * osc; b = b * osc;
                    *(u32x4*)(dst + (size_t)row * ld) = pack8(a, b);
                    *(u32x4*)(dst + (size_t)row * ld + 32) = pack8(c, d);
                    if (m & 1) asm volatile("" ::: "memory");
                }
        } else {
            const int hv = wc - 2;
#pragma unroll
            for (int ai = 0; ai < 2; ++ai)
#pragma unroll
                for (int m = 0; m < 4; ++m) {
                    const int row = row0 + ai * 128 + m * 16;
                    const float rs = rsbuf[ai * 128 + wr * 64 + m * 16 + fr];
                    bf16_t* vb = VT + ((size_t)(hv * 64 + 8 * fq)) * SEQ + row;
#pragma unroll
                    for (int bj = 0; bj < 2; ++bj)
#pragma unroll
                        for (int n = 0; n < 2; ++n) { const f32x4 v = acc[ai][bj][m][n] * rs;
                            const unsigned w0 = cvt_pk_bf16(v[0], v[1]), w1 = cvt_pk_bf16(v[2], v[3]);
                            bf16_t* p = vb + (size_t)(32 * bj + 4 * n) * SEQ;
                            p[0] = (bf16_t)(w0 & 0xffffu); p[SEQ] = (bf16_t)(w0 >> 16); p[2 * SEQ] = (bf16_t)(w1 & 0xffffu); p[3 * SEQ] = (bf16_t)(w1 >> 16); }
                }
        }
    }
};

struct EpiBranch {
    static constexpr bool DUAL = true;
    static constexpr bool NEEDS_RS = false;
    bf16_t* big;
    template <bool END> __device__ __forceinline__ void run(f32x4 (&acc)[2][2][4][2], const Unit& u, int wr, int wc, int fr, int fq) const {
        const int row0 = (u.pm & 31) * 256 + wr * 64 + fr, col0 = u.pn * 256 + wc * 32 + 8 * fq;
        bf16_t* const Mb = big + (size_t)(u.pm >> 5) * ARE + AR_U / 2; const bf16_t* const G = big + (size_t)(u.pm >> 5) * ARE + AR_G / 2 + (END ? 1024 : 0);
#pragma unroll
        for (int ai = 0; ai < 2; ++ai) {
            u32x4 gw[4][2];
#pragma unroll
            for (int m = 0; m < 4; ++m)
#pragma unroll
                for (int bj = 0; bj < 2; ++bj) gw[m][bj] = *(const u32x4*)(G + (size_t)(row0 + ai * 128 + m * 16) * 2048 + col0 + bj * 128);
            asm volatile("" ::: "memory");
#pragma unroll
            for (int m = 0; m < 4; ++m)
#pragma unroll
                for (int bj = 0; bj < 2; ++bj) { const u32x4 g4 = gw[m][bj];
                    const f32x4 v0 = acc[ai][bj][m][0] * (f32x4){bf_lo(g4.x), bf_hi(g4.x), bf_lo(g4.y), bf_hi(g4.y)};
                    const f32x4 v1 = acc[ai][bj][m][1] * (f32x4){bf_lo(g4.z), bf_hi(g4.z), bf_lo(g4.w), bf_hi(g4.w)};
                    if (END) *(u32x4*)(Mb + (size_t)(row0 + ai * 128 + m * 16) * DM + col0 + bj * 128) = pack8(v0, v1);
                    else { acc[ai][bj][m][0] = v0; acc[ai][bj][m][1] = v1; } }
            asm volatile("" ::: "memory");
        }
    }
    __device__ __forceinline__ void mid(f32x4 (&acc)[2][2][4][2], const Unit& u, int wr, int wc, int fr, int fq) const { run<false>(acc, u, wr, wc, fr, fq); }
    __device__ __forceinline__ void operator()(f32x4 (&acc)[2][2][4][2], const Unit& u, int wr, int wc, int fr, int fq, const PG8_LAS float* rsbuf) const { run<true>(acc, u, wr, wc, fr, fq); }
};

__device__ __forceinline__ int sigma_inv4(int d4) { return d4 < 16 ? 8 * ((d4 >> 2) & 1) + 4 * (d4 >> 3) : d4; }
template <int MODE> __device__ __forceinline__ int src_group(int n0, bool& perm) {
    perm = false;
    if (MODE == 0) return n0;
    if (MODE == 1) { const int tile = n0 >> 8, loc = n0 & 255; return loc < 128 ? tile * 128 + loc : FF + tile * 128 + (loc - 128); }
    if (n0 < 512) return n0;
    if (n0 >= 1280) { const int j = (n0 >> 8) - 5, loc = n0 & 255; return 1280 + ((loc >> 7) ? 1024 : 0) + 128 * j + (loc & 127); }
    const int pn = n0 >> 8, loc = n0 & 255, bj = loc >> 7, wc = (loc & 127) >> 5;
    if (pn < 4) { perm = (bj == 0); return 512 + (4 * (pn - 2) + wc) * 64 + 32 * bj; }
    if (wc < 2) { perm = (bj == 0); return 1024 + 64 * wc + 32 * bj; }
    return 1152 + 64 * (wc - 2) + 32 * bj;
}
struct TItem { const float* W; const float* gain; bf16_t* WT; int K, N, mode, r; };
__device__ __forceinline__ int src_group_rt(int mode, int n0, bool& perm) { if (mode == 1) return src_group<1>(n0, perm); if (mode == 2) return src_group<2>(n0, perm); return src_group<0>(n0, perm); }
__device__ __forceinline__ void titem_load(const TItem& t, int lane, f32x4 (&v)[8], int& jd) {
    const int nblk = t.N / 32, kb = t.r / nblk, nb = t.r % nblk, k0 = 64 * kb, n0 = 32 * nb;
    bool perm; const int src = src_group_rt(t.mode, n0, perm);
    const int c4 = 4 * (lane & 7); jd = perm ? sigma_inv4(c4) : c4;
#pragma unroll
    for (int i = 0; i < 8; ++i) { const int kk = 8 * i + (lane >> 3);
        v[i] = *(const f32x4*)(t.W + (size_t)(k0 + kk) * t.N + src + c4);
        if (t.gain) v[i] = v[i] * t.gain[k0 + kk]; }
}
__device__ __forceinline__ void titem_store(const TItem& t, LAS float* scr, int lane, const f32x4 (&v)[8], int jd) {
    const int nblk = t.N / 32, kb = t.r / nblk, nb = t.r % nblk, k0 = 64 * kb, n0 = 32 * nb;
#pragma unroll
    for (int i = 0; i < 8; ++i) { const int kk = 8 * i + (lane >> 3); LAS float* s = scr + kk * 33 + jd; s[0] = v[i][0]; s[1] = v[i][1]; s[2] = v[i][2]; s[3] = v[i][3]; }
    asm volatile("s_waitcnt lgkmcnt(0)" ::: "memory");
    const int c = lane & 7;
#pragma unroll
    for (int j = 0; j < 4; ++j) { const int n = (lane >> 3) + 8 * j; const LAS float* s = scr + (8 * c) * 33 + n;
        u32x4 o; o.x = cvt_pk_bf16(s[0 * 33], s[1 * 33]); o.y = cvt_pk_bf16(s[2 * 33], s[3 * 33]); o.z = cvt_pk_bf16(s[4 * 33], s[5 * 33]); o.w = cvt_pk_bf16(s[6 * 33], s[7 * 33]);
        *(u32x4*)(t.WT + (size_t)(n0 + n) * t.K + k0 + 8 * c) = o; }
    asm volatile("s_waitcnt lgkmcnt(0)" ::: "memory");
}

struct Args {
    const float *x, *ln1, *wgu1, *wd1, *lnm, *win, *poolw, *pscale, *wpb, *qn, *kn, *sinks, *wab, *wout, *ln2, *wgu2, *wd2;
    float* out; unsigned char* ws;
};

__device__ __forceinline__ float wave_sum(float v) {
#pragma unroll
    for (int o = 1; o < 64; o <<= 1) v += __shfl_xor(v, o);
    return v;
}

__device__ __forceinline__ void prologue(const Args& a, LAS unsigned char* lds, int gw, int NGW, int lane, int wave) {
    LAS float* scr = (LAS float*)(lds + wave * 16384);
    unsigned char* ws = a.ws;
    constexpr int I_GU = (DM / 64) * (NGU / 32), I_D = (FF / 64) * (DM / 32), I_IN = (DM / 64) * (NIN / 32), I_AB = (AD / 64) * (DM / 32), I_OUT = (DM / 64) * (DM / 32);
    constexpr int I_LAYER = 2 * I_GU + 2 * I_D + I_IN + I_AB + I_OUT;
    auto resolve = [&](int it) {
        TItem t; const int l = it / I_LAYER; int r = it % I_LAYER;
        unsigned char* wl = ws + WS_W + (size_t)l * LW_BYTES;
        if (r < I_GU) { t = TItem{a.wgu1 + (size_t)l * DM * NGU, a.ln1 + l * DM, (bf16_t*)(wl + LW_GU1), DM, NGU, 1, r}; return t; } r -= I_GU;
        if (r < I_GU) { t = TItem{a.wgu2 + (size_t)l * DM * NGU, a.ln2 + l * DM, (bf16_t*)(wl + LW_GU2), DM, NGU, 1, r}; return t; } r -= I_GU;
        if (r < I_D) { t = TItem{a.wd1 + (size_t)l * FF * DM, nullptr, (bf16_t*)(wl + LW_D1), FF, DM, 0, r}; return t; } r -= I_D;
        if (r < I_D) { t = TItem{a.wd2 + (size_t)l * FF * DM, nullptr, (bf16_t*)(wl + LW_D2), FF, DM, 0, r}; return t; } r -= I_D;
        if (r < I_IN) { t = TItem{a.win + (size_t)l * DM * NIN, a.lnm + l * DM, (bf16_t*)(wl + LW_IN), DM, NIN, 2, r}; return t; } r -= I_IN;
        if (r < I_AB) { t = TItem{a.wab + (size_t)l * AD * DM, nullptr, (bf16_t*)(wl + LW_AB), AD, DM, 0, r}; return t; } r -= I_AB;
        t = TItem{a.wout + (size_t)l * DM * DM, nullptr, (bf16_t*)(wl + LW_OUT), DM, DM, 0, r}; return t;
    };
    for (int it = gw; it < DEPTH * I_LAYER; it += 2 * NGW) {
        const bool hasB = it + NGW < DEPTH * I_LAYER;
        const TItem A = resolve(it), B = resolve(hasB ? it + NGW : it);
        f32x4 va[8], vb[8]; int ja, jb;
        titem_load(A, lane, va, ja); titem_load(B, lane, vb, jb);
        titem_store(A, scr, lane, va, ja);
        if (hasB) titem_store(B, scr, lane, vb, jb);
    }
    for (int it = gw; it < DEPTH * 1024; it += NGW) {
        const int l = it >> 10, r = it & 1023, nb = r & 15, co = (r >> 4) & 15, g = r >> 8;
        const int n = nb * 64 + lane, c0 = co * 8;
        const float* pw = a.poolw + ((size_t)(l * 4 + g) * 128 + c0) * 128;
        const float* sc = a.pscale + l * PD + g * 128;
        const float* wp = a.wpb + ((size_t)l * PD + g * 128) * DM + n;
        float s[8] = {0.f, 0.f, 0.f, 0.f, 0.f, 0.f, 0.f, 0.f};
#pragma unroll 16
        for (int d = 0; d < 128; ++d) { const float w = sc[d] * wp[(size_t)d * DM];
#pragma unroll
            for (int i = 0; i < 8; ++i) s[i] += pw[i * 128 + d] * w; }
        u32x4 o; o.x = cvt_pk_bf16(s[0], s[1]); o.y = cvt_pk_bf16(s[2], s[3]); o.z = cvt_pk_bf16(s[4], s[5]); o.w = cvt_pk_bf16(s[6], s[7]);
        *(u32x4*)((bf16_t*)(ws + WS_W + (size_t)l * LW_BYTES + LW_PB) + (size_t)n * PD + g * 128 + c0) = o;
    }
    float* rope = (float*)(ws + WS_ROPE);
    for (int i = gw * 64 + lane; i < SEQ * 8; i += NGW * 64) { const int t = i >> 3, k = i & 7;
        const float inv = powf(500000.0f, -(float)(2 * k) / 16.0f); const float ang = (float)t * inv; float sn, cs; sincosf(ang, &sn, &cs);
        rope[t * 16 + k] = cs; rope[t * 16 + 8 + k] = sn; }
    float* ss = (float*)(ws + WS_SS);
    bf16_t* XB = (bf16_t*)(ws + WS_XB);
    for (int row0 = gw; row0 < M; row0 += 4 * NGW) {
        f32x4 v[4][4];
#pragma unroll
        for (int q = 0; q < 4; ++q) { const int row = row0 + q * NGW; const float* xr = a.x + (size_t)(row < M ? row : row0) * DM + 8 * lane;
#pragma unroll
            for (int j = 0; j < 2; ++j) { v[q][2 * j] = *(const f32x4*)(xr + 512 * j); v[q][2 * j + 1] = *(const f32x4*)(xr + 512 * j + 4); } }
#pragma unroll
        for (int q = 0; q < 4; ++q) { const int row = row0 + q * NGW; if (row >= M) break; float sq = 0.f;
#pragma unroll
            for (int j = 0; j < 2; ++j) { const f32x4 v0 = v[q][2 * j], v1 = v[q][2 * j + 1];
                sq += (v0[0] * v0[0] + v0[1] * v0[1]) + (v0[2] * v0[2] + v0[3] * v0[3]) + (v1[0] * v1[0] + v1[1] * v1[1]) + (v1[2] * v1[2] + v1[3] * v1[3]);
                *(u32x4*)(XB + (size_t)row * DM + 8 * lane + 512 * j) = pack8(v0, v1); }
            sq = wave_sum(sq);
            if (lane < 4) ss[(size_t)row * 4 + lane] = lane == 0 ? sq : 0.f; }
    }
}

__device__ __forceinline__ void unpack8(const u32x4 w, float (&f)[8]) { f[0] = bf_lo(w.x); f[1] = bf_hi(w.x); f[2] = bf_lo(w.y); f[3] = bf_hi(w.y); f[4] = bf_lo(w.z); f[5] = bf_hi(w.z); f[6] = bf_lo(w.w); f[7] = bf_hi(w.w); }

template <int W> __device__ __forceinline__ void pool_item(const bf16_t* __restrict__ U, bf16_t* __restrict__ Dp, int row0, int ch) {
    const int tl0 = row0;
    u32x4 r[W + 7];
#pragma unroll
    for (int j = 0; j < W + 7; ++j) { const int dt = j - (W - 1);
        r[j] = (tl0 + dt >= 0) ? *(const u32x4*)(U + (size_t)(row0 + dt) * PD + ch) : (u32x4){0u, 0u, 0u, 0u}; }
    float s[8] = {0.f, 0.f, 0.f, 0.f, 0.f, 0.f, 0.f, 0.f};
#pragma unroll
    for (int j = 0; j < W - 1; ++j) { float f[8]; unpack8(r[j], f);
#pragma unroll
        for (int e = 0; e < 8; ++e) s[e] += f[e]; }
#pragma unroll
    for (int i = 0; i < 8; ++i) {
        float cur[8]; unpack8(r[W - 1 + i], cur);
#pragma unroll
        for (int e = 0; e < 8; ++e) s[e] += cur[e];
        const int cnt = (tl0 + i + 1 < W) ? (tl0 + i + 1) : W;
        const float inv = 1.0f / (float)cnt;
        f32x4 o0, o1;
#pragma unroll
        for (int e = 0; e < 4; ++e) { o0[e] = s[e] * inv - cur[e]; o1[e] = s[4 + e] * inv - cur[4 + e]; }
        *(u32x4*)(Dp + (size_t)(row0 + i) * PD + ch) = pack8(o0, o1);
        float old[8]; unpack8(r[i], old);
#pragma unroll
        for (int e = 0; e < 8; ++e) s[e] -= old[e];
    }
}

__device__ __forceinline__ void attn_item(const bf16_t* __restrict__ Q, const bf16_t* __restrict__ Kb, const bf16_t* __restrict__ VT, bf16_t* __restrict__ Oa, float sink2, int h, int q0, int lane) {
    const int i = lane & 31, hi = lane >> 5, hk = h >> 2;
    const size_t rowbase = 0;
    const int pi = (i & 19) | ((i & 4) << 1) | ((i & 8) >> 1);
    const int jmin = q0 >= 128 ? 0 : 4 - (q0 >> 5);
    bf16x8 qf[4];
    const bf16_t* qp = Q + (rowbase + q0 + i) * AD + h * 64 + 8 * hi;
#pragma unroll
    for (int s = 0; s < 4; ++s) qf[s] = *(const bf16x8*)(qp + 16 * s);
    bf16x8 kf[5][4];
#pragma unroll
    for (int j = 0; j < 5; ++j) { const int jj = j < jmin ? jmin : j;
        const bf16_t* kp = Kb + (rowbase + q0 - 128 + 32 * jj + pi) * KVD + hk * 64 + 8 * hi;
#pragma unroll
        for (int s = 0; s < 4; ++s) kf[j][s] = *(const bf16x8*)(kp + 16 * s); }
    f32x16 sc[5];
#pragma unroll
    for (int j = 0; j < 5; ++j) { sc[j] = (f32x16){};
#pragma unroll
        for (int s = 0; s < 4; ++s) sc[j] = __builtin_amdgcn_mfma_f32_32x32x16_bf16(kf[j][s], qf[s], sc[j], 0, 0, 0); }
    asm volatile("" ::: "memory");
    bf16x8 vf[5][2][2];
    const bf16_t* vp = VT + ((size_t)(hk * 64 + i)) * SEQ + 8 * hi;
#pragma unroll
    for (int j = 0; j < 5; ++j) { const int jj = j < jmin ? jmin : j; const int kb = q0 - 128 + 32 * jj;
#pragma unroll
        for (int ks = 0; ks < 2; ++ks)
#pragma unroll
            for (int dt = 0; dt < 2; ++dt) vf[j][ks][dt] = *(const bf16x8*)(vp + (size_t)(32 * dt) * SEQ + kb + 16 * ks); }
    const float NEG = -INFINITY;
    float mx = sink2;
#pragma unroll
    for (int j = 0; j < 5; ++j) {
#pragma unroll
        for (int r = 0; r < 16; ++r) { const int kk = 8 * hi + (r & 7) + 16 * (r >> 3);
            bool ok = j >= jmin;
            if (j == 0) ok = ok && (kk >= i + 1);
            if (j == 4) ok = ok && (kk <= i);
            sc[j][r] = ok ? sc[j][r] : NEG;
            mx = fmaxf(mx, sc[j][r]); } }
    mx = fmaxf(mx, __shfl_xor(mx, 32));
    float l = 0.f;
    f32x16 o[2]; o[0] = (f32x16){}; o[1] = (f32x16){};
#pragma unroll
    for (int j = 0; j < 5; ++j) {
#pragma unroll
        for (int r = 0; r < 16; ++r) { sc[j][r] = __builtin_amdgcn_exp2f(sc[j][r] - mx); l += sc[j][r]; }
        u32x4 pw[2];
        pw[0] = (u32x4){cvt_pk_bf16(sc[j][0], sc[j][1]), cvt_pk_bf16(sc[j][2], sc[j][3]), cvt_pk_bf16(sc[j][4], sc[j][5]), cvt_pk_bf16(sc[j][6], sc[j][7])};
        pw[1] = (u32x4){cvt_pk_bf16(sc[j][8], sc[j][9]), cvt_pk_bf16(sc[j][10], sc[j][11]), cvt_pk_bf16(sc[j][12], sc[j][13]), cvt_pk_bf16(sc[j][14], sc[j][15])};
#pragma unroll
        for (int ks = 0; ks < 2; ++ks)
#pragma unroll
            for (int dt = 0; dt < 2; ++dt) o[dt] = __builtin_amdgcn_mfma_f32_32x32x16_bf16(vf[j][ks][dt], __builtin_bit_cast(bf16x8, pw[ks]), o[dt], 0, 0, 0);
        __builtin_amdgcn_sched_barrier(0);
    }
    l += __shfl_xor(l, 32);
    l += __builtin_amdgcn_exp2f(sink2 - mx);
    const float rl = 1.0f / l;
    bf16_t* op = Oa + (rowbase + q0 + i) * AD + h * 64 + 4 * hi;
#pragma unroll
    for (int dt = 0; dt < 2; ++dt)
#pragma unroll
        for (int rq = 0; rq < 4; ++rq) { u32x2 w; w.x = cvt_pk_bf16(o[dt][4 * rq] * rl, o[dt][4 * rq + 1] * rl); w.y = cvt_pk_bf16(o[dt][4 * rq + 2] * rl, o[dt][4 * rq + 3] * rl);
            *(u32x2*)(op + 32 * dt + 8 * rq) = w; }
}

__device__ __forceinline__ void mixer_phase(const Args& a, int l, int vgw, int NGW, int lane) {
    asm volatile("" : "+v"(lane));
    unsigned char* ws = a.ws;
    const int wpb = NGW / NB;
    const int b = vgw / wpb, lw = vgw % wpb;
    const bf16_t* ar = (const bf16_t*)(ws + WS_BIG) + (size_t)b * ARE;
    const bf16_t* U = ar + AR_U / 2; bf16_t* Dp = (bf16_t*)(ws + WS_DP) + (size_t)b * SEQ * PD;
    for (int it = lw + (((SEQ / 32) * 4 - 1 - lw) / wpb) * wpb; it >= 0; it -= wpb) {
        const int g = it & 3, chunk = it >> 2;
        const int row0 = chunk * 32 + (lane >> 4) * 8, ch = g * 128 + (lane & 15) * 8;
        if (g == 0) pool_item<2>(U, Dp, row0, ch); else if (g == 1) pool_item<4>(U, Dp, row0, ch); else if (g == 2) pool_item<8>(U, Dp, row0, ch); else pool_item<16>(U, Dp, row0, ch);
    }
    const bf16_t* Q = ar + AR_Q / 2; const bf16_t* Kb = ar + AR_K / 2; const bf16_t* VT = ar + AR_VT / 2; bf16_t* Oa = (bf16_t*)(ws + WS_OA) + (size_t)b * SEQ * AD;
    for (int it = lw + ((8 * (SEQ / 32) - 1 - lw) / wpb) * wpb; it >= 0; it -= wpb) {
        const int g = it & 3, qb = (it >> 2) & 255, hk = it >> 10, h = hk * 4 + g;
        const float sink2 = a.sinks[l * 8 + h] * LOG2E;
        attn_item(Q, Kb, VT, Oa, sink2, h, qb * 32, lane);
    }
}

#define XB_TMO      128
#define XB_XCNT(j)  (256  + 64 * (j))
#define XB_XSUB(j)  (1280 + 64 * (j))
#define XB_XGEN(j)  (2304 + 64 * (j))
#define XB_TOP      3328
#define XB_TOPGEN   3392
#define XCD_BAR_WORDS 3456
#define XB_SPIN_CAP (1u << 22)
__device__ __forceinline__ unsigned xb_ld(unsigned* p)              { return __hip_atomic_load(p, __ATOMIC_RELAXED, __HIP_MEMORY_SCOPE_AGENT); }
__device__ __forceinline__ unsigned xb_add(unsigned* p, unsigned v) { return __hip_atomic_fetch_add(p, v, __ATOMIC_RELAXED, __HIP_MEMORY_SCOPE_AGENT); }
__device__ __forceinline__ unsigned xb_xcc_id() { return (unsigned)__builtin_amdgcn_s_getreg((3 << 11) | 20) & 0xFu; }
#define XB_SPIN(cond, bar) do { unsigned _sp = 0; while (cond) { __builtin_amdgcn_s_sleep(1); \
    if ((++_sp & 255u) == 0u) { if (xb_ld(&(bar)[XB_TMO])) break; if (_sp > XB_SPIN_CAP) { atomicAdd(&(bar)[XB_TMO], 1u); break; } } } } while (0)
__device__ __forceinline__ void xcd_barrier_complete(unsigned* bar, unsigned x, unsigned& nloc, unsigned& nx, unsigned& uniform8) {
    const unsigned G = gridDim.x * gridDim.y * gridDim.z;
    unsigned sum, cnt, mine, bad, sp = 0u;
    for (;;) {
        sum = 0u; cnt = 0u; mine = 0u; bad = 0u;
#pragma unroll
        for (unsigned j = 0; j < 16; ++j) { const unsigned c = xb_ld(&bar[XB_XCNT(j)]); sum += c; cnt += (c > 0u) ? 1u : 0u; mine = (j == x) ? c : mine; bad |= (j < 8u) ? (c * 8u != G) : (c != 0u); }
        if (sum == G) break;
        __builtin_amdgcn_s_sleep(1);
        if ((++sp & 255u) == 0u) { if (xb_ld(&bar[XB_TMO])) break; if (sp > XB_SPIN_CAP) { atomicAdd(&bar[XB_TMO], 1u); break; } }
    }
    nloc = mine > 0u ? mine : 1u; nx = cnt > 0u ? cnt : 1u; uniform8 = (sum == G && bad == 0u) ? 1u : 0u;
}
__device__ __forceinline__ void xcd_barrier(unsigned* bar_in, volatile LAS unsigned* st, bool local) {
    asm volatile("s_waitcnt vmcnt(0)" ::: "memory");
    __syncthreads();
    int t0 = threadIdx.x; asm volatile("" : "+v"(t0));
    if (t0 == 0) {
        unsigned* bar = bar_in; asm volatile("" : "+s"(bar));
        const unsigned bx = xb_xcc_id();
        __builtin_amdgcn_s_waitcnt(0);
        unsigned nloc = st[0], nx = st[1];
        if (nloc == 0u) { unsigned u8; xcd_barrier_complete(bar, bx, nloc, nx, u8); st[0] = nloc; st[1] = nx; st[2] = u8; }
        const unsigned old = xb_add(&bar[XB_XSUB(bx)], 1u);
        const unsigned gen = old / nloc;
        if (old + 1u == (gen + 1u) * nloc) {
            __builtin_amdgcn_fence(__ATOMIC_RELEASE, "agent");
            asm volatile("s_waitcnt vmcnt(0)" ::: "memory");
            if (!local) {
                const unsigned og = xb_add(&bar[XB_TOP], 1u);
                const unsigned tg = og / nx;
                if (og + 1u == (tg + 1u) * nx) xb_add(&bar[XB_TOPGEN], 1u);
                else XB_SPIN(xb_ld(&bar[XB_TOPGEN]) == tg, bar);
            }
            __builtin_amdgcn_fence(__ATOMIC_ACQUIRE, "agent");
            xb_add(&bar[XB_XGEN(bx)], 1u);
            asm volatile("s_waitcnt vmcnt(0)" ::: "memory");
        } else {
            XB_SPIN(xb_ld(&bar[XB_XGEN(bx)]) == gen, bar);
            __builtin_amdgcn_fence(__ATOMIC_ACQUIRE, "agent");
            asm volatile("s_waitcnt vmcnt(0)" ::: "memory");
        }
    }
    __syncthreads();
}

#ifndef SKEW_TICKS
#define SKEW_TICKS 0
#endif
constexpr int LDS_BYTES = 131072 + 8192;
__global__ void __launch_bounds__(512, 2) fwd_kernel(Args a) {
    extern __shared__ __attribute__((aligned(16))) unsigned char lds_raw[];
    LAS unsigned char* lds = (LAS unsigned char*)lds_raw;
    cg::grid_group grid = cg::this_grid();
    grid.sync();
    volatile LAS unsigned* ctlw = (volatile LAS unsigned*)(lds + 131072);
    if (threadIdx.x < 16) ctlw[threadIdx.x] = 0u;
    __syncthreads();
    if (threadIdx.x == 0) { const unsigned x = xb_xcc_id(); ctlw[12] = xb_add(&((unsigned*)a.ws)[XB_XCNT(x)], 1u); ctlw[13] = x; }
    const int tid = threadIdx.x, lane = tid & 63, wave = __builtin_amdgcn_readfirstlane(tid >> 6);
    const int G = gridDim.x, NGW = G * 8;
    unsigned char* ws = a.ws;
    float* ss = (float*)(ws + WS_SS);
    bf16_t* XB = (bf16_t*)(ws + WS_XB); bf16_t* BIG = (bf16_t*)(ws + WS_BIG);

    prologue(a, lds, blockIdx.x * 8 + wave, NGW, lane, wave);
    xcd_barrier((unsigned*)a.ws, ctlw + 8, false);
    const bool local = (G == 256) && (__builtin_amdgcn_readfirstlane(ctlw[10]) == 1u);
    const int vc = local ? (int)(__builtin_amdgcn_readfirstlane(ctlw[12]) * 8u + __builtin_amdgcn_readfirstlane(ctlw[13])) : (int)blockIdx.x;
    const int vgw = (G == 256) ? ((vc & 7) * 256 + (vc >> 3) * 8 + wave) : (vc * 8 + wave);
#define GRID_SYNC() xcd_barrier((unsigned*)a.ws, ctlw + 8, local)
#if SKEW_TICKS > 0
    if (local) { const unsigned long long t0 = __builtin_amdgcn_s_memrealtime(); const unsigned long long w = (unsigned long long)(vc & 7) * SKEW_TICKS;
        while (__builtin_amdgcn_s_memrealtime() - t0 < w) __builtin_amdgcn_s_sleep(32); }
#endif

#pragma unroll 1
    for (int l = 0; l < DEPTH; ++l) {
        const unsigned char* wl = ws + WS_W + (size_t)l * LW_BYTES;
        pg8::StaticOrder S;
        constexpr size_t PAD_H = ARENA - (size_t)SEQ * FF * 2, PAD_MB = ARENA - (size_t)SEQ * DM * 2;
#pragma unroll 1
        for (int hf = 0; hf < 2; ++hf) {
            {
                pg8::Gemm g{XB, (const bf16_t*)(wl + LW_GU1), M, NGU, DM, 0, nullptr, nullptr}; S.init(M / 2, NGU, G, vc, 0, 0, hf);
                EpiGU E{BIG, ss};
                pg8::gemm_phase<EpiGU, true>(lds, g, S, E);
            }
            GRID_SYNC();
            {
                pg8::Gemm g{BIG, (const bf16_t*)(wl + LW_D1), M, DM, FF, PAD_H, nullptr, nullptr}; S.init(M / 2, DM, G, vc, 0, 1, hf);
                EpiResid E{XB, nullptr, ss, 0.5f};
                pg8::gemm_phase<EpiResid, true, true>(lds, g, S, E);
            }
            GRID_SYNC();
        }
        {
            pg8::Gemm g{XB, (const bf16_t*)(wl + LW_IN), M, NIN, DM, 0, nullptr, nullptr}; S.init(M, NIN, G, vc);
            EpiWin E{ss, BIG, a.qn + l * 64, a.kn + l * 64, (const float*)(ws + WS_ROPE)};
            pg8::gemm_phase<EpiWin, true>(lds, g, S, E);
        }
        GRID_SYNC();
        mixer_phase(a, l, vgw, NGW, lane);
        GRID_SYNC();
        {
            S.init(M, DM, G, vc, 1);
            pg8::Gemm g{(const bf16_t*)(ws + WS_DP), (const bf16_t*)(wl + LW_PB), M, DM, PD, 0, (const bf16_t*)(ws + WS_OA), (const bf16_t*)(wl + LW_AB)};
            EpiBranch E{BIG};
            pg8::gemm_phase<EpiBranch, true>(lds, g, S, E);
        }
        GRID_SYNC();
        {
            pg8::Gemm g{BIG + AR_U / 2, (const bf16_t*)(wl + LW_OUT), M, DM, DM, PAD_MB, nullptr, nullptr}; S.init(M, DM, G, vc, 0, 1);
            EpiResid E{XB, nullptr, ss, 1.0f};
            pg8::gemm_phase<EpiResid, true>(lds, g, S, E);
        }
        GRID_SYNC();
#pragma unroll 1
        for (int hf = 0; hf < 2; ++hf) {
            {
                pg8::Gemm g{XB, (const bf16_t*)(wl + LW_GU2), M, NGU, DM, 0, nullptr, nullptr}; S.init(M / 2, NGU, G, vc, 0, 0, hf);
                EpiGU E{BIG, ss};
                pg8::gemm_phase<EpiGU, true>(lds, g, S, E);
            }
            GRID_SYNC();
            {
                pg8::Gemm g{BIG, (const bf16_t*)(wl + LW_D2), M, DM, FF, PAD_H, nullptr, nullptr}; S.init(M / 2, DM, G, vc, 0, 1, hf);
                EpiResid E{XB, l < DEPTH - 1 ? nullptr : a.out, l < DEPTH - 1 ? ss : nullptr, 0.5f};
                pg8::gemm_phase<EpiResid, true, true>(lds, g, S, E);
            }
            if (l < DEPTH - 1 || hf == 0) GRID_SYNC();
        }
    }
}

extern "C" void kernel_launch(void* const* d_in, const int* in_sizes, int n_in, void* d_out, int out_size, void* d_ws, size_t ws_size, hipStream_t stream) {
    static int grid = 0;
    if (grid == 0) {
        if (n_in != 17 || in_sizes[0] != M * DM || out_size != M * DM || ws_size < WS_END) { fprintf(stderr, "kernel_launch: unexpected shapes (n_in %d, in0 %d, out %d, ws %zu)\n", n_in, n_in > 0 ? in_sizes[0] : -1, out_size, ws_size); grid = -1; return; }
        int dev = 0, cus = 0, per_cu = 0;
        if (hipGetDevice(&dev) != hipSuccess || hipDeviceGetAttribute(&cus, hipDeviceAttributeMultiprocessorCount, dev) != hipSuccess) { grid = -1; return; }
        if (hipFuncSetAttribute((const void*)fwd_kernel, hipFuncAttributeMaxDynamicSharedMemorySize, LDS_BYTES) != hipSuccess) { fprintf(stderr, "kernel_launch: hipFuncSetAttribute failed\n"); grid = -1; return; }
        if (hipOccupancyMaxActiveBlocksPerMultiprocessor(&per_cu, (const void*)fwd_kernel, 512, LDS_BYTES) != hipSuccess || per_cu < 1) per_cu = 1;
        (void)hipGetLastError();
        grid = cus * per_cu;
    }
    if (grid < 0) return;
    Args a{};
    a.x = (const float*)d_in[0]; a.ln1 = (const float*)d_in[1]; a.wgu1 = (const float*)d_in[2]; a.wd1 = (const float*)d_in[3]; a.lnm = (const float*)d_in[4];
    a.win = (const float*)d_in[5]; a.poolw = (const float*)d_in[6]; a.pscale = (const float*)d_in[7]; a.wpb = (const float*)d_in[8]; a.qn = (const float*)d_in[9];
    a.kn = (const float*)d_in[10]; a.sinks = (const float*)d_in[11]; a.wab = (const float*)d_in[12]; a.wout = (const float*)d_in[13]; a.ln2 = (const float*)d_in[14];
    a.wgu2 = (const float*)d_in[15]; a.wd2 = (const float*)d_in[16];
    a.out = (float*)d_out; a.ws = (unsigned char*)d_ws;
    void* args[] = {&a};
    if (hipMemsetAsync(d_ws, 0, 16384, stream) != hipSuccess) { fprintf(stderr, "kernel_launch: hipMemsetAsync failed\n"); return; }
    const hipError_t e = hipLaunchCooperativeKernel((const void*)fwd_kernel, dim3(grid), dim3(512), args, LDS_BYTES, stream);
    if (e != hipSuccess) fprintf(stderr, "kernel_launch: cooperative launch failed: %s (grid %d)\n", hipGetErrorString(e), grid);
}
```

```cpp
#include <hip/hip_runtime.h>
#include <hip/hip_cooperative_groups.h>
#include <cstdio>
#include <cstdint>
namespace cg = cooperative_groups;

namespace pg8 {
#define PG8_LAS __attribute__((address_space(3)))
typedef unsigned short bf16_t;
typedef short bf16x8 __attribute__((ext_vector_type(8)));
typedef float f32x4 __attribute__((ext_vector_type(4)));
typedef unsigned u32x4 __attribute__((ext_vector_type(4)));
typedef unsigned u32x2 __attribute__((ext_vector_type(2)));
constexpr int BM = 256, BK = 64, HALF = 128, HTB = HALF * BK * 2, STAGE_BYTES = 8 * HTB, NXCD = 8, WGM = 8;

__host__ __device__ __forceinline__ int lds_byte(int r, int c) { const int st = (r >> 4) * 2 + (c >> 5), rr = r & 15, cc = c & 31, ob = rr * 64 + cc * 2; return st * 1024 + (ob ^ (((ob >> 9) & 1) << 5)); }
__host__ __device__ __forceinline__ void stage_rc(int b, int& R, int& C) { const int st = b / 1024, sb = b % 1024, swz = sb ^ (((sb >> 9) & 1) << 5); R = (st >> 1) * 16 + swz / 64; C = (st & 1) * 32 + (swz % 64) / 2; }
__host__ __device__ __forceinline__ int perm32(int rho) { const int n = rho >> 4, i = rho & 15; return 8 * (i >> 2) + 4 * n + (i & 3); }

struct Unit { int pm, pn, part; };
struct Gemm { const bf16_t* A; const bf16_t* Bt; int M, N, K; size_t a_pad; const bf16_t* A2; const bf16_t* Bt2; };

struct StaticOrder {
    int nM, nN, nwg, G, c, dual, rev, half;
    __host__ __device__ void init(int M, int N, int G_, int c_, int dual_ = 0, int rev_ = 0, int half_ = -1) { nM = M / BM; nN = N / BM; nwg = nM * nN; G = G_; c = c_; dual = dual_; rev = rev_; half = half_; }
    __host__ __device__ bool next(int i, Unit& u) const {
        u.part = dual ? (i & 1) : 0;
        int it = dual ? (i >> 1) : i; const int nsteps = (nwg - c + G - 1) / G; if (it >= nsteps) return false; if (rev) it = nsteps - 1 - it;
        const long L = (long)it * G + c; if (L >= nwg) return false;
        int wgid = (int)L; { const int q = nwg / NXCD, r = nwg % NXCD, xcd = wgid % NXCD, off = wgid / NXCD; wgid = (xcd < r ? xcd * (q + 1) : r * (q + 1) + (xcd - r) * q) + off; }
        const int nig = WGM * nN, gid = wgid / nig, fm = gid * WGM, gsz = (nM - fm) < WGM ? (nM - fm) : WGM;
        u.pm = fm + ((wgid % nig) % gsz); u.pn = (wgid % nig) / gsz;
        if (half >= 0) u.pm = u.pm + ((u.pm >> 4) << 4) + 16 * half;
        return true;
    }
};

__device__ __forceinline__ unsigned cvt_pk_bf16(float lo, float hi) { unsigned r; asm volatile("v_cvt_pk_bf16_f32 %0, %1, %2" : "=v"(r) : "v"(lo), "v"(hi)); return r; }

template <class Epi, bool ALIGN_EPI, bool ABLK = false>
__device__ __forceinline__ void gemm_phase(PG8_LAS unsigned char* lds, const Gemm g, const StaticOrder& S, const Epi& E) {
    int tid = threadIdx.x; asm volatile("" : "+v"(tid));
    const int wid = __builtin_amdgcn_readfirstlane(tid >> 6), lane = tid & 63, wr = wid >> 2, wc = wid & 3, fr = lane & 15, fq = lane >> 4;
    const int K = g.K, nt = K / BK;
    unsigned voffA[2], voffB[2];
#pragma unroll
    for (int i = 0; i < 2; ++i) { int R, C; stage_rc(tid * 16 + i * 8192, R, C); const int Rb = (R & ~31) + perm32(R & 31);
        voffA[i] = (unsigned)(R * (ABLK ? BK : K) + C) * 2u; voffB[i] = (unsigned)(Rb * K + C) * 2u; }
    const size_t kstep = (size_t)(BK * 2);
    const size_t hstep = (size_t)HALF * K * 2;
    const size_t tstep = 2 * hstep;
    const size_t kstepA = ABLK ? (size_t)(BM * BK * 2) : kstep, hstepA = ABLK ? (size_t)(HALF * BK * 2) : hstep;
    const unsigned ldsw = (unsigned)wid * 1024u;
    const int aoff = lds_byte(wr * 64 + fr, fq * 8), boff = lds_byte(wc * 32 + fr, fq * 8);
#define PG8_SA(b, h) (((b) * 2 + (h)) * HTB)
#define PG8_SB(b, h) ((4 + (b) * 2 + (h)) * HTB)
#define PG8_STAGE(bufoff, gbase, voff) do { _Pragma("unroll") for (int _i = 0; _i < 2; ++_i) \
        __builtin_amdgcn_global_load_lds((const unsigned*)((const char*)(gbase) + (voff)[_i]), (PG8_LAS unsigned*)(lds + (bufoff) + ldsw + _i * 8192), 16, 0, 0); } while (0)
#define PG8_LDA(dst, b, h) do { _Pragma("unroll") for (int m = 0; m < 4; ++m) _Pragma("unroll") for (int k = 0; k < 2; ++k) dst[m][k] = *(const PG8_LAS bf16x8*)(lds + PG8_SA(b, h) + aoff + m * 2048 + k * 1024); } while (0)
#define PG8_LDB(dst, b, h) do { _Pragma("unroll") for (int n = 0; n < 2; ++n) _Pragma("unroll") for (int k = 0; k < 2; ++k) dst[n][k] = *(const PG8_LAS bf16x8*)(lds + PG8_SB(b, h) + boff + n * 2048 + k * 1024); } while (0)
#define PG8_MMA(ai, bj, At, Bt) do { __builtin_amdgcn_s_setprio(1); _Pragma("unroll") for (int m = 0; m < 4; ++m) _Pragma("unroll") for (int n = 0; n < 2; ++n) _Pragma("unroll") for (int k = 0; k < 2; ++k) \
        acc[ai][bj][m][n] = __builtin_amdgcn_mfma_f32_16x16x32_bf16(Bt[n][k], At[m][k], acc[ai][bj][m][n], 0, 0, 0); __builtin_amdgcn_s_setprio(0); } while (0)
#define PG8_WAIT_V(n) asm volatile("s_waitcnt vmcnt(" #n ")" ::: "memory")
#define PG8_WAIT_L(n) asm volatile("s_waitcnt lgkmcnt(" #n ")" ::: "memory")
#define PG8_BAR __builtin_amdgcn_s_barrier()
#define PG8_SCHED __builtin_amdgcn_sched_barrier(0)
    Unit cur, nxt; int ui = 0;
    if (!S.next(0, cur)) return;
    f32x4 acc[2][2][4][2];
#pragma unroll
    for (int a = 0; a < 2; ++a)
#pragma unroll
        for (int b = 0; b < 2; ++b)
#pragma unroll
            for (int m = 0; m < 4; ++m)
#pragma unroll
                for (int n = 0; n < 2; ++n) acc[a][b][m][n] = (f32x4){0.f, 0.f, 0.f, 0.f};
    bf16x8 At[4][2], B0[2][2], B1[2][2];
    typedef float f32x2 __attribute__((ext_vector_type(2)));
    f32x2 rsp = (f32x2){0.f, 0.f};
    PG8_LAS float* rsbuf = (PG8_LAS float*)(lds + STAGE_BYTES + 1024);
    const char* cA = (const char*)(Epi::DUAL && cur.part ? g.A2 : g.A) + (size_t)cur.pm * tstep + (size_t)(cur.pm >> 5) * g.a_pad; const char* cB = (const char*)(Epi::DUAL && cur.part ? g.Bt2 : g.Bt) + (size_t)cur.pn * tstep;
    PG8_STAGE(PG8_SB(0, 0), cB, voffB); PG8_STAGE(PG8_SB(0, 1), cB + hstep, voffB); PG8_STAGE(PG8_SA(0, 0), cA, voffA); PG8_STAGE(PG8_SA(0, 1), cA + hstepA, voffA);
    if (wr == 1) PG8_BAR;
    PG8_WAIT_V(2); PG8_BAR;
    PG8_STAGE(PG8_SB(1, 0), cB + kstep, voffB); PG8_STAGE(PG8_SA(1, 0), cA + kstepA, voffA); PG8_STAGE(PG8_SB(1, 1), cB + hstep + kstep, voffB);
    PG8_WAIT_V(6); PG8_BAR;
    for (;;) {
        const bool has_next = S.next(ui + 1, nxt);
        const char* nA = has_next ? (const char*)(Epi::DUAL && nxt.part ? g.A2 : g.A) + (size_t)nxt.pm * tstep + (size_t)(nxt.pm >> 5) * g.a_pad : cA; const char* nB = has_next ? (const char*)(Epi::DUAL && nxt.part ? g.Bt2 : g.Bt) + (size_t)nxt.pn * tstep : cB;
        for (int t = 0; t < nt; t += 2) {
            const bool last = (t == nt - 2);
            const char* a1 = cA + (size_t)(t + 1) * kstepA;
            const char* a2 = last ? nA : cA + (size_t)(t + 2) * kstepA; const char* b2 = last ? nB : cB + (size_t)(t + 2) * kstep;
            const char* a3 = a2 + kstepA; const char* b3 = b2 + kstep;
            if constexpr (Epi::NEEDS_RS) { if (last) rsp = *(const f32x2*)(E.ss + ((size_t)(cur.pm * BM + (tid >> 1)) * 4 + (tid & 1) * 2)); }
            PG8_LDB(B0, 0, 0); PG8_LDB(B1, 0, 1); PG8_SCHED; PG8_LDA(At, 0, 0); PG8_STAGE(PG8_SA(1, 1), a1 + hstepA, voffA);
            PG8_WAIT_V(8); PG8_WAIT_L(0); PG8_BAR; PG8_MMA(0, 0, At, B0); PG8_MMA(0, 1, At, B1); PG8_BAR; PG8_SCHED;
            PG8_LDA(At, 0, 1); PG8_STAGE(PG8_SB(0, 0), b2, voffB); PG8_STAGE(PG8_SB(0, 1), b2 + hstep, voffB); PG8_STAGE(PG8_SA(0, 0), a2, voffA);
            PG8_WAIT_V(8); PG8_WAIT_L(0); PG8_BAR; PG8_MMA(1, 0, At, B0); PG8_MMA(1, 1, At, B1); PG8_BAR; PG8_SCHED;
            PG8_LDB(B0, 1, 0); PG8_LDB(B1, 1, 1); PG8_SCHED; PG8_LDA(At, 1, 0); PG8_STAGE(PG8_SA(0, 1), a2 + hstepA, voffA);
            PG8_WAIT_V(8); PG8_WAIT_L(0); PG8_BAR; PG8_MMA(0, 0, At, B0); PG8_MMA(0, 1, At, B1); PG8_BAR; PG8_SCHED;
            PG8_LDA(At, 1, 1); PG8_STAGE(PG8_SB(1, 0), b3, voffB); PG8_STAGE(PG8_SB(1, 1), b3 + hstep, voffB); PG8_STAGE(PG8_SA(1, 0), a3, voffA);
            PG8_WAIT_V(8); PG8_WAIT_L(0); PG8_BAR; PG8_MMA(1, 0, At, B0); PG8_MMA(1, 1, At, B1); PG8_BAR; PG8_SCHED;
        }
        if constexpr (ALIGN_EPI) { if (wr == 0) PG8_BAR; }
        if constexpr (Epi::NEEDS_RS) {
            float sq = rsp[0] + rsp[1];
            sq += __shfl_xor(sq, 1);
            if ((tid & 1) == 0) rsbuf[tid >> 1] = __builtin_amdgcn_rsqf(sq * (1.f / 1024.f) + 1e-6f);
            PG8_WAIT_L(0); PG8_BAR; asm volatile("" ::: "memory");
        }
        bool keep = false;
        if constexpr (Epi::DUAL) { if (cur.part == 0) { E.mid(acc, cur, wr, wc, fr, fq); keep = true; } else E(acc, cur, wr, wc, fr, fq, rsbuf); }
        else E(acc, cur, wr, wc, fr, fq, rsbuf);
        if (!has_next) break;
        if (!keep)
#pragma unroll
        for (int a = 0; a < 2; ++a)
#pragma unroll
            for (int b = 0; b < 2; ++b)
#pragma unroll
                for (int m = 0; m < 4; ++m)
#pragma unroll
                    for (int n = 0; n < 2; ++n) acc[a][b][m][n] = (f32x4){0.f, 0.f, 0.f, 0.f};
        cur = nxt; cA = nA; cB = nB; ++ui;
        if constexpr (ALIGN_EPI) { if (wr == 1) PG8_BAR; }
    }
    PG8_WAIT_V(0);
    if constexpr (!ALIGN_EPI) { if (wr == 0) PG8_BAR; }
    PG8_BAR;
#undef PG8_SA
#undef PG8_SB
#undef PG8_STAGE
#undef PG8_LDA
#undef PG8_LDB
#undef PG8_MMA
#undef PG8_WAIT_V
#undef PG8_WAIT_L
#undef PG8_BAR
#undef PG8_SCHED
}
}

using pg8::bf16_t; using pg8::bf16x8; using pg8::f32x4; using pg8::u32x4; using pg8::u32x2; using pg8::Unit; using pg8::cvt_pk_bf16;
typedef float f32x16 __attribute__((ext_vector_type(16)));
#define LAS __attribute__((address_space(3)))

constexpr int DM = 1024, NB = 8, SEQ = 8192, DEPTH = 4, M = NB * SEQ;
constexpr int FF = 2816, NGU = 2 * FF, NIN = 3328, PD = 512, AD = 512, KVD = 128;
constexpr float EPSN = 1e-6f, LOG2E = 1.4426950408889634f;
constexpr float QSCALE = 0.125f * LOG2E;

constexpr size_t MiB = 1u << 20;
constexpr size_t WS_ROPE = 1 * MiB;
constexpr size_t WS_SS = 2 * MiB;
constexpr size_t WS_W = 8 * MiB;
constexpr size_t LW_GU1 = 0, LW_D1 = 11 * MiB, LW_IN = LW_D1 + 11 * MiB / 2, LW_PB = LW_IN + 13 * MiB / 2, LW_AB = LW_PB + 1 * MiB,
                 LW_OUT = LW_AB + 1 * MiB, LW_GU2 = LW_OUT + 2 * MiB, LW_D2 = LW_GU2 + 11 * MiB, LW_BYTES = LW_D2 + 11 * MiB / 2;
static_assert(LW_BYTES == 87 * MiB / 2, "weights per layer");
constexpr size_t WS_XB = 184 * MiB;
constexpr size_t WS_DP = 312 * MiB;
constexpr size_t WS_OA = 376 * MiB;
constexpr size_t WS_BIG = 440 * MiB;
constexpr size_t ARENA = 52 * MiB, AR_U = 0, AR_Q = 8 * MiB, AR_K = 16 * MiB, AR_VT = 18 * MiB, AR_G = 20 * MiB, WS_END = WS_BIG + 8 * ARENA;
constexpr size_t ARE = ARENA / 2;
static_assert(WS_W + 4 * LW_BYTES <= WS_XB && (size_t)SEQ * FF * 2 <= ARENA && AR_G + (size_t)SEQ * 2048 * 2 <= ARENA && WS_END <= 1024 * MiB, "d_ws map");

__device__ __forceinline__ float bf_lo(unsigned w) { return __uint_as_float(w << 16); }
__device__ __forceinline__ float bf_hi(unsigned w) { return __uint_as_float(w & 0xffff0000u); }
__device__ __forceinline__ u32x4 pack8(const f32x4 a, const f32x4 b) { u32x4 w; w.x = cvt_pk_bf16(a[0], a[1]); w.y = cvt_pk_bf16(a[2], a[3]); w.z = cvt_pk_bf16(b[0], b[1]); w.w = cvt_pk_bf16(b[2], b[3]); return w; }

struct EpiGU {
    static constexpr bool DUAL = false;
    static constexpr bool NEEDS_RS = true;
    bf16_t* H; const float* ss;
    __device__ __forceinline__ void operator()(const f32x4 (&acc)[2][2][4][2], const Unit& u, int wr, int wc, int fr, int fq, const PG8_LAS float* rsbuf) const {
        bf16_t* hb = H + (size_t)(u.pm >> 5) * ARE + ((size_t)((u.pm & 31) * (FF / 64) + 2 * u.pn + (wc >> 1)) * 256 + wr * 64 + fr) * 64 + (wc & 1) * 32 + 8 * fq;
#pragma unroll
        for (int ai = 0; ai < 2; ++ai)
#pragma unroll
            for (int m = 0; m < 4; ++m) {
                const float rs = rsbuf[ai * 128 + wr * 64 + m * 16 + fr];
                const float c1 = -LOG2E * rs, rs2 = rs * rs;
                f32x4 h[2];
#pragma unroll
                for (int n = 0; n < 2; ++n) { const f32x4 ag = acc[ai][0][m][n], au = acc[ai][1][m][n];
                    const f32x4 t = ag * c1; f32x4 e;
#pragma unroll
                    for (int k = 0; k < 4; ++k) e[k] = __builtin_amdgcn_exp2f(t[k]);
                    const f32x4 d = e + 1.0f; f32x4 r;
#pragma unroll
                    for (int k = 0; k < 4; ++k) r[k] = __builtin_amdgcn_rcpf(d[k]);
                    h[n] = ((ag * au) * rs2) * r; }
                *(u32x4*)(hb + (ai * 128 + m * 16) * 64) = pack8(h[0], h[1]);
            }
    }
};

struct EpiResid {
    static constexpr bool DUAL = false;
    static constexpr bool NEEDS_RS = false;
    bf16_t* xb; float* outf; float* ss_out; float scale;
    __device__ __forceinline__ void operator()(const f32x4 (&acc)[2][2][4][2], const Unit& u, int wr, int wc, int fr, int fq, const PG8_LAS float* rsbuf) const {
        const int row0 = u.pm * 256 + wr * 64 + fr, col0 = u.pn * 256 + wc * 32 + 8 * fq;
        PG8_LAS float* sqbuf = (PG8_LAS float*)(rsbuf + 256);
#pragma unroll
        for (int ai = 0; ai < 2; ++ai) {
            u32x4 xw[4][2];
#pragma unroll
            for (int m = 0; m < 4; ++m)
#pragma unroll
                for (int bj = 0; bj < 2; ++bj) xw[m][bj] = *(const u32x4*)(xb + (size_t)(row0 + ai * 128 + m * 16) * DM + col0 + bj * 128);
            asm volatile("" ::: "memory");
#pragma unroll
            for (int m = 0; m < 4; ++m) {
                const int row = row0 + ai * 128 + m * 16; float sq = 0.f;
#pragma unroll
                for (int bj = 0; bj < 2; ++bj) { const size_t off = (size_t)row * DM + col0 + bj * 128;
                    const u32x4 x4 = xw[m][bj];
                    const f32x4 v0 = (f32x4){bf_lo(x4.x), bf_hi(x4.x), bf_lo(x4.y), bf_hi(x4.y)} + acc[ai][bj][m][0] * scale;
                    const f32x4 v1 = (f32x4){bf_lo(x4.z), bf_hi(x4.z), bf_lo(x4.w), bf_hi(x4.w)} + acc[ai][bj][m][1] * scale;
                    if (outf) { *(f32x4*)(outf + off) = v0; *(f32x4*)(outf + off + 4) = v1; }
                    else { const u32x4 w = pack8(v0, v1); *(u32x4*)(xb + off) = w;
                        const f32x4 r0 = (f32x4){bf_lo(w.x), bf_hi(w.x), bf_lo(w.y), bf_hi(w.y)}, r1 = (f32x4){bf_lo(w.z), bf_hi(w.z), bf_lo(w.w), bf_hi(w.w)};
                        sq += (r0[0] * r0[0] + r0[1] * r0[1]) + (r0[2] * r0[2] + r0[3] * r0[3]) + (r1[0] * r1[0] + r1[1] * r1[1]) + (r1[2] * r1[2] + r1[3] * r1[3]); } }
                if (ss_out) { sq += __shfl_xor(sq, 16); sq += __shfl_xor(sq, 32);
                    if (fq == 0) sqbuf[(ai * 128 + wr * 64 + m * 16 + fr) * 4 + wc] = sq; }
            }
            asm volatile("" ::: "memory");
        }
        if (ss_out) {
            asm volatile("s_waitcnt lgkmcnt(0)" ::: "memory"); __builtin_amdgcn_s_barrier(); asm volatile("" ::: "memory");
            const int t = (wr * 4 + wc) * 64 + fq * 16 + fr;
            if (t < 256) { const f32x4 p = *(const PG8_LAS f32x4*)(sqbuf + t * 4); ss_out[(size_t)(u.pm * 256 + t) * 4 + u.pn] = (p[0] + p[1]) + (p[2] + p[3]); }
        }
    }
};

struct EpiWin {
    static constexpr bool DUAL = false;
    static constexpr bool NEEDS_RS = true;
    const float* ss; bf16_t* big; const float *qn, *kn, *rope;
    __device__ __forceinline__ void operator()(const f32x4 (&acc)[2][2][4][2], const Unit& u, int wr, int wc, int fr, int fq, const PG8_LAS float* rsbuf) const {
        const int row0 = (u.pm & 31) * 256 + wr * 64 + fr, pn = u.pn;
        bf16_t* const ar = big + (size_t)(u.pm >> 5) * ARE;
        bf16_t* const U = ar + AR_U / 2; bf16_t* const Q = ar + AR_Q / 2; bf16_t* const Kb = ar + AR_K / 2; bf16_t* const VT = ar + AR_VT / 2; bf16_t* const G = ar + AR_G / 2;
        if (pn < 2) {
            bf16_t* dst = U + pn * 256 + wc * 32 + 8 * fq;
#pragma unroll
            for (int ai = 0; ai < 2; ++ai)
#pragma unroll
                for (int m = 0; m < 4; ++m) {
                    const int row = row0 + ai * 128 + m * 16;
                    const float rs = rsbuf[ai * 128 + wr * 64 + m * 16 + fr];
#pragma unroll
                    for (int bj = 0; bj < 2; ++bj) *(u32x4*)(dst + (size_t)row * 512 + bj * 128) = pack8(acc[ai][bj][m][0] * rs, acc[ai][bj][m][1] * rs);
                }
        } else if (pn >= 5) {
            bf16_t* dst = G + (pn - 5) * 128 + wc * 32 + 8 * fq;
#pragma unroll
            for (int ai = 0; ai < 2; ++ai)
#pragma unroll
                for (int m = 0; m < 4; ++m) {
                    const int row = row0 + ai * 128 + m * 16;
                    const float c1 = -LOG2E * rsbuf[ai * 128 + wr * 64 + m * 16 + fr];
                    f32x4 rr[2], ga[2];
#pragma unroll
                    for (int n = 0; n < 2; ++n) { const f32x4 tp = acc[ai][0][m][n] * c1, ta = acc[ai][1][m][n] * c1; f32x4 dp, da;
#pragma unroll
                        for (int e = 0; e < 4; ++e) { dp[e] = 1.f + __builtin_amdgcn_exp2f(fminf(tp[e], 60.f)); da[e] = 1.f + __builtin_amdgcn_exp2f(fminf(ta[e], 60.f)); }
#pragma unroll
                        for (int e = 0; e < 4; ++e) { rr[n][e] = da[e] * __builtin_amdgcn_rcpf(dp[e]); ga[n][e] = __builtin_amdgcn_rcpf(da[e]); } }
                    *(u32x4*)(dst + (size_t)row * 2048) = pack8(rr[0], rr[1]);
                    *(u32x4*)(dst + (size_t)row * 2048 + 1024) = pack8(ga[0], ga[1]);
                }
        } else if (pn < 4 || wc < 2) {
            const bool isq = pn < 4;
            const float* gain = isq ? qn : kn;
            const f32x4 g00 = *(const f32x4*)(gain + (fq < 2 ? 4 * fq : 8 * fq)), g01 = *(const f32x4*)(gain + (fq < 2 ? 4 * fq + 8 : 8 * fq + 4));
            const f32x4 g10 = *(const f32x4*)(gain + 32 + 8 * fq), g11 = *(const f32x4*)(gain + 36 + 8 * fq);
            const float osc = isq ? QSCALE : 1.f;
            bf16_t* dst = isq ? Q + (4 * (pn - 2) + wc) * 64 : Kb + wc * 64; const int ld = isq ? AD : KVD;
            dst += 8 * fq;
#pragma unroll
            for (int ai = 0; ai < 2; ++ai)
#pragma unroll
                for (int m = 0; m < 4; ++m) {
                    const int row = row0 + ai * 128 + m * 16;
                    const float rs = rsbuf[ai * 128 + wr * 64 + m * 16 + fr];
                    f32x4 a = acc[ai][0][m][0] * rs, b = acc[ai][0][m][1] * rs, c = acc[ai][1][m][0] * rs, d = acc[ai][1][m][1] * rs;
                    float sq = (a[0] * a[0] + a[1] * a[1]) + (a[2] * a[2] + a[3] * a[3]) + (b[0] * b[0] + b[1] * b[1]) + (b[2] * b[2] + b[3] * b[3])
                             + (c[0] * c[0] + c[1] * c[1]) + (c[2] * c[2] + c[3] * c[3]) + (d[0] * d[0] + d[1] * d[1]) + (d[2] * d[2] + d[3] * d[3]);
                    sq += __shfl_xor(sq, 16); sq += __shfl_xor(sq, 32);
                    const float rq = __builtin_amdgcn_rsqf(sq * (1.f / 64.f) + EPSN);
                    a = a * rq * g00; b = b * rq * g01; c = c * (rq * osc) * g10; d = d * (rq * osc) * g11;
                    const int t = row & (SEQ - 1);
                    const f32x4 cs = *(const f32x4*)(rope + t * 16 + 4 * (fq & 1)), sn = *(const f32x4*)(rope + t * 16 + 8 + 4 * (fq & 1));
                    const f32x4 ra = a * cs - b * sn, rb = b * cs + a * sn;
                    if (fq < 2) { a = ra; b = rb; }
                    a = a * osc; b = b * osc;
                    *(u32x4*)(dst + (size_t)row * ld) = pack8(a, b);
                    *(u32x4*)(dst + (size_t)row * ld + 32) = pack8(c, d);
                    if (m & 1) asm volatile("" ::: "memory");
                }
        } else {
            const int hv = wc - 2;
#pragma unroll
            for (int ai = 0; ai < 2; ++ai)
#pragma unroll
                for (int m = 0; m < 4; ++m) {
                    const int row = row0 + ai * 128 + m * 16;
                    const float rs = rsbuf[ai * 128 + wr * 64 + m * 16 + fr];
                    bf16_t* vb = VT + ((size_t)(hv * 64 + 8 * fq)) * SEQ + row;
#pragma unroll
                    for (int bj = 0; bj < 2; ++bj)
#pragma unroll
                        for (int n = 0; n < 2; ++n) { const f32x4 v = acc[ai][bj][m][n] * rs;
                            const unsigned w0 = cvt_pk_bf16(v[0], v[1]), w1 = cvt_pk_bf16(v[2], v[3]);
                            bf16_t* p = vb + (size_t)(32 * bj + 4 * n) * SEQ;
                            p[0] = (bf16_t)(w0 & 0xffffu); p[SEQ] = (bf16_t)(w0 >> 16); p[2 * SEQ] = (bf16_t)(w1 & 0xffffu); p[3 * SEQ] = (bf16_t)(w1 >> 16); }
                }
        }
    }
};

struct EpiBranch {
    static constexpr bool DUAL = true;
    static constexpr bool NEEDS_RS = false;
    bf16_t* big;
    template <bool END> __device__ __forceinline__ void run(f32x4 (&acc)[2][2][4][2], const Unit& u, int wr, int wc, int fr, int fq) const {
        const int row0 = (u.pm & 31) * 256 + wr * 64 + fr, col0 = u.pn * 256 + wc * 32 + 8 * fq;
        bf16_t* const Mb = big + (size_t)(u.pm >> 5) * ARE + AR_U / 2; const bf16_t* const G = big + (size_t)(u.pm >> 5) * ARE + AR_G / 2 + (END ? 1024 : 0);
#pragma unroll
        for (int ai = 0; ai < 2; ++ai) {
            u32x4 gw[4][2];
#pragma unroll
            for (int m = 0; m < 4; ++m)
#pragma unroll
                for (int bj = 0; bj < 2; ++bj) gw[m][bj] = *(const u32x4*)(G + (size_t)(row0 + ai * 128 + m * 16) * 2048 + col0 + bj * 128);
            asm volatile("" ::: "memory");
#pragma unroll
            for (int m = 0; m < 4; ++m)
#pragma unroll
                for (int bj = 0; bj < 2; ++bj) { const u32x4 g4 = gw[m][bj];
                    const f32x4 v0 = acc[ai][bj][m][0] * (f32x4){bf_lo(g4.x), bf_hi(g4.x), bf_lo(g4.y), bf_hi(g4.y)};
                    const f32x4 v1 = acc[ai][bj][m][1] * (f32x4){bf_lo(g4.z), bf_hi(g4.z), bf_lo(g4.w), bf_hi(g4.w)};
                    if (END) *(u32x4*)(Mb + (size_t)(row0 + ai * 128 + m * 16) * DM + col0 + bj * 128) = pack8(v0, v1);
                    else { acc[ai][bj][m][0] = v0; acc[ai][bj][m][1] = v1; } }
            asm volatile("" ::: "memory");
        }
    }
    __device__ __forceinline__ void mid(f32x4 (&acc)[2][2][4][2], const Unit& u, int wr, int wc, int fr, int fq) const { run<false>(acc, u, wr, wc, fr, fq); }
    __device__ __forceinline__ void operator()(f32x4 (&acc)[2][2][4][2], const Unit& u, int wr, int wc, int fr, int fq, const PG8_LAS float* rsbuf) const { run<true>(acc, u, wr, wc, fr, fq); }
};

__device__ __forceinline__ int sigma_inv4(int d4) { return d4 < 16 ? 8 * ((d4 >> 2) & 1) + 4 * (d4 >> 3) : d4; }
template <int MODE> __device__ __forceinline__ int src_group(int n0, bool& perm) {
    perm = false;
    if (MODE == 0) return n0;
    if (MODE == 1) { const int tile = n0 >> 8, loc = n0 & 255; return loc < 128 ? tile * 128 + loc : FF + tile * 128 + (loc - 128); }
    if (n0 < 512) return n0;
    if (n0 >= 1280) { const int j = (n0 >> 8) - 5, loc = n0 & 255; return 1280 + ((loc >> 7) ? 1024 : 0) + 128 * j + (loc & 127); }
    const int pn = n0 >> 8, loc = n0 & 255, bj = loc >> 7, wc = (loc & 127) >> 5;
    if (pn < 4) { perm = (bj == 0); return 512 + (4 * (pn - 2) + wc) * 64 + 32 * bj; }
    if (wc < 2) { perm = (bj == 0); return 1024 + 64 * wc + 32 * bj; }
    return 1152 + 64 * (wc - 2) + 32 * bj;
}
struct TItem { const float* W; const float* gain; bf16_t* WT; int K, N, mode, r; };
__device__ __forceinline__ int src_group_rt(int mode, int n0, bool& perm) { if (mode == 1) return src_group<1>(n0, perm); if (mode == 2) return src_group<2>(n0, perm); return src_group<0>(n0, perm); }
__device__ __forceinline__ void titem_load(const TItem& t, int lane, f32x4 (&v)[8], int& jd) {
    const int nblk = t.N / 32, kb = t.r / nblk, nb = t.r % nblk, k0 = 64 * kb, n0 = 32 * nb;
    bool perm; const int src = src_group_rt(t.mode, n0, perm);
    const int c4 = 4 * (lane & 7); jd = perm ? sigma_inv4(c4) : c4;
#pragma unroll
    for (int i = 0; i < 8; ++i) { const int kk = 8 * i + (lane >> 3);
        v[i] = *(const f32x4*)(t.W + (size_t)(k0 + kk) * t.N + src + c4);
        if (t.gain) v[i] = v[i] * t.gain[k0 + kk]; }
}
__device__ __forceinline__ void titem_store(const TItem& t, LAS float* scr, int lane, const f32x4 (&v)[8], int jd) {
    const int nblk = t.N / 32, kb = t.r / nblk, nb = t.r % nblk, k0 = 64 * kb, n0 = 32 * nb;
#pragma unroll
    for (int i = 0; i < 8; ++i) { const int kk = 8 * i + (lane >> 3); LAS float* s = scr + kk * 33 + jd; s[0] = v[i][0]; s[1] = v[i][1]; s[2] = v[i][2]; s[3] = v[i][3]; }
    asm volatile("s_waitcnt lgkmcnt(0)" ::: "memory");
    const int c = lane & 7;
#pragma unroll
    for (int j = 0; j < 4; ++j) { const int n = (lane >> 3) + 8 * j; const LAS float* s = scr + (8 * c) * 33 + n;
        u32x4 o; o.x = cvt_pk_bf16(s[0 * 33], s[1 * 33]); o.y = cvt_pk_bf16(s[2 * 33], s[3 * 33]); o.z = cvt_pk_bf16(s[4 * 33], s[5 * 33]); o.w = cvt_pk_bf16(s[6 * 33], s[7 * 33]);
        *(u32x4*)(t.WT + (size_t)(n0 + n) * t.K + k0 + 8 * c) = o; }
    asm volatile("s_waitcnt lgkmcnt(0)" ::: "memory");
}

struct Args {
    const float *x, *ln1, *wgu1, *wd1, *lnm, *win, *poolw, *pscale, *wpb, *qn, *kn, *sinks, *wab, *wout, *ln2, *wgu2, *wd2;
    float* out; unsigned char* ws;
};

__device__ __forceinline__ float wave_sum(float v) {
#pragma unroll
    for (int o = 1; o < 64; o <<= 1) v += __shfl_xor(v, o);
    return v;
}

__device__ __forceinline__ void prologue(const Args& a, LAS unsigned char* lds, int gw, int NGW, int lane, int wave) {
    LAS float* scr = (LAS float*)(lds + wave * 16384);
    unsigned char* ws = a.ws;
    constexpr int I_GU = (DM / 64) * (NGU / 32), I_D = (FF / 64) * (DM / 32), I_IN = (DM / 64) * (NIN / 32), I_AB = (AD / 64) * (DM / 32), I_OUT = (DM / 64) * (DM / 32);
    constexpr int I_LAYER = 2 * I_GU + 2 * I_D + I_IN + I_AB + I_OUT;
    auto resolve = [&](int it) {
        TItem t; const int l = it / I_LAYER; int r = it % I_LAYER;
        unsigned char* wl = ws + WS_W + (size_t)l * LW_BYTES;
        if (r < I_GU) { t = TItem{a.wgu1 + (size_t)l * DM * NGU, a.ln1 + l * DM, (bf16_t*)(wl + LW_GU1), DM, NGU, 1, r}; return t; } r -= I_GU;
        if (r < I_GU) { t = TItem{a.wgu2 + (size_t)l * DM * NGU, a.ln2 + l * DM, (bf16_t*)(wl + LW_GU2), DM, NGU, 1, r}; return t; } r -= I_GU;
        if (r < I_D) { t = TItem{a.wd1 + (size_t)l * FF * DM, nullptr, (bf16_t*)(wl + LW_D1), FF, DM, 0, r}; return t; } r -= I_D;
        if (r < I_D) { t = TItem{a.wd2 + (size_t)l * FF * DM, nullptr, (bf16_t*)(wl + LW_D2), FF, DM, 0, r}; return t; } r -= I_D;
        if (r < I_IN) { t = TItem{a.win + (size_t)l * DM * NIN, a.lnm + l * DM, (bf16_t*)(wl + LW_IN), DM, NIN, 2, r}; return t; } r -= I_IN;
        if (r < I_AB) { t = TItem{a.wab + (size_t)l * AD * DM, nullptr, (bf16_t*)(wl + LW_AB), AD, DM, 0, r}; return t; } r -= I_AB;
        t = TItem{a.wout + (size_t)l * DM * DM, nullptr, (bf16_t*)(wl + LW_OUT), DM, DM, 0, r}; return t;
    };
    for (int it = gw; it < DEPTH * I_LAYER; it += 2 * NGW) {
        const bool hasB = it + NGW < DEPTH * I_LAYER;
        const TItem A = resolve(it), B = resolve(hasB ? it + NGW : it);
        f32x4 va[8], vb[8]; int ja, jb;
        titem_load(A, lane, va, ja); titem_load(B, lane, vb, jb);
        titem_store(A, scr, lane, va, ja);
        if (hasB) titem_store(B, scr, lane, vb, jb);
    }
    for (int it = gw; it < DEPTH * 1024; it += NGW) {
        const int l = it >> 10, r = it & 1023, nb = r & 15, co = (r >> 4) & 15, g = r >> 8;
        const int n = nb * 64 + lane, c0 = co * 8;
        const float* pw = a.poolw + ((size_t)(l * 4 + g) * 128 + c0) * 128;
        const float* sc = a.pscale + l * PD + g * 128;
        const float* wp = a.wpb + ((size_t)l * PD + g * 128) * DM + n;
        float s[8] = {0.f, 0.f, 0.f, 0.f, 0.f, 0.f, 0.f, 0.f};
#pragma unroll 16
        for (int d = 0; d < 128; ++d) { const float w = sc[d] * wp[(size_t)d * DM];
#pragma unroll
            for (int i = 0; i < 8; ++i) s[i] += pw[i * 128 + d] * w; }
        u32x4 o; o.x = cvt_pk_bf16(s[0], s[1]); o.y = cvt_pk_bf16(s[2], s[3]); o.z = cvt_pk_bf16(s[4], s[5]); o.w = cvt_pk_bf16(s[6], s[7]);
        *(u32x4*)((bf16_t*)(ws + WS_W + (size_t)l * LW_BYTES + LW_PB) + (size_t)n * PD + g * 128 + c0) = o;
    }
    float* rope = (float*)(ws + WS_ROPE);
    for (int i = gw * 64 + lane; i < SEQ * 8; i += NGW * 64) { const int t = i >> 3, k = i & 7;
        const float inv = powf(500000.0f, -(float)(2 * k) / 16.0f); const float ang = (float)t * inv; float sn, cs; sincosf(ang, &sn, &cs);
        rope[t * 16 + k] = cs; rope[t * 16 + 8 + k] = sn; }
    float* ss = (float*)(ws + WS_SS);
    bf16_t* XB = (bf16_t*)(ws + WS_XB);
    for (int row0 = gw; row0 < M; row0 += 4 * NGW) {
        f32x4 v[4][4];
#pragma unroll
        for (int q = 0; q < 4; ++q) { const int row = row0 + q * NGW; const float* xr = a.x + (size_t)(row < M ? row : row0) * DM + 8 * lane;
#pragma unroll
            for (int j = 0; j < 2; ++j) { v[q][2 * j] = *(const f32x4*)(xr + 512 * j); v[q][2 * j + 1] = *(const f32x4*)(xr + 512 * j + 4); } }
#pragma unroll
        for (int q = 0; q < 4; ++q) { const int row = row0 + q * NGW; if (row >= M) break; float sq = 0.f;
#pragma unroll
            for (int j = 0; j < 2; ++j) { const f32x4 v0 = v[q][2 * j], v1 = v[q][2 * j + 1];
                sq += (v0[0] * v0[0] + v0[1] * v0[1]) + (v0[2] * v0[2] + v0[3] * v0[3]) + (v1[0] * v1[0] + v1[1] * v1[1]) + (v1[2] * v1[2] + v1[3] * v1[3]);
                *(u32x4*)(XB + (size_t)row * DM + 8 * lane + 512 * j) = pack8(v0, v1); }
            sq = wave_sum(sq);
            if (lane < 4) ss[(size_t)row * 4 + lane] = lane == 0 ? sq : 0.f; }
    }
}

__device__ __forceinline__ void unpack8(const u32x4 w, float (&f)[8]) { f[0] = bf_lo(w.x); f[1] = bf_hi(w.x); f[2] = bf_lo(w.y); f[3] = bf_hi(w.y); f[4] = bf_lo(w.z); f[5] = bf_hi(w.z); f[6] = bf_lo(w.w); f[7] = bf_hi(w.w); }

template <int W> __device__ __forceinline__ void pool_item(const bf16_t* __restrict__ U, bf16_t* __restrict__ Dp, int row0, int ch) {
    const int tl0 = row0;
    u32x4 r[W + 7];
#pragma unroll
    for (int j = 0; j < W + 7; ++j) { const int dt = j - (W - 1);
        r[j] = (tl0 + dt >= 0) ? *(const u32x4*)(U + (size_t)(row0 + dt) * PD + ch) : (u32x4){0u, 0u, 0u, 0u}; }
    float s[8] = {0.f, 0.f, 0.f, 0.f, 0.f, 0.f, 0.f, 0.f};
#pragma unroll
    for (int j = 0; j < W - 1; ++j) { float f[8]; unpack8(r[j], f);
#pragma unroll
        for (int e = 0; e < 8; ++e) s[e] += f[e]; }
#pragma unroll
    for (int i = 0; i < 8; ++i) {
        float cur[8]; unpack8(r[W - 1 + i], cur);
#pragma unroll
        for (int e = 0; e < 8; ++e) s[e] += cur[e];
        const int cnt = (tl0 + i + 1 < W) ? (tl0 + i + 1) : W;
        const float inv = 1.0f / (float)cnt;
        f32x4 o0, o1;
#pragma unroll
        for (int e = 0; e < 4; ++e) { o0[e] = s[e] * inv - cur[e]; o1[e] = s[4 + e] * inv - cur[4 + e]; }
        *(u32x4*)(Dp + (size_t)(row0 + i) * PD + ch) = pack8(o0, o1);
        float old[8]; unpack8(r[i], old);
#pragma unroll
        for (int e = 0; e < 8; ++e) s[e] -= old[e];
    }
}

__device__ __forceinline__ void attn_item(const bf16_t* __restrict__ Q, const bf16_t* __restrict__ Kb, const bf16_t* __restrict__ VT, bf16_t* __restrict__ Oa, float sink2, int h, int q0, int lane) {
    const int i = lane & 31, hi = lane >> 5, hk = h >> 2;
    const size_t rowbase = 0;
    const int pi = (i & 19) | ((i & 4) << 1) | ((i & 8) >> 1);
    const int jmin = q0 >= 128 ? 0 : 4 - (q0 >> 5);
    bf16x8 qf[4];
    const bf16_t* qp = Q + (rowbase + q0 + i) * AD + h * 64 + 8 * hi;
#pragma unroll
    for (int s = 0; s < 4; ++s) qf[s] = *(const bf16x8*)(qp + 16 * s);
    bf16x8 kf[5][4];
#pragma unroll
    for (int j = 0; j < 5; ++j) { const int jj = j < jmin ? jmin : j;
        const bf16_t* kp = Kb + (rowbase + q0 - 128 + 32 * jj + pi) * KVD + hk * 64 + 8 * hi;
#pragma unroll
        for (int s = 0; s < 4; ++s) kf[j][s] = *(const bf16x8*)(kp + 16 * s); }
    f32x16 sc[5];
#pragma unroll
    for (int j = 0; j < 5; ++j) { sc[j] = (f32x16){};
#pragma unroll
        for (int s = 0; s < 4; ++s) sc[j] = __builtin_amdgcn_mfma_f32_32x32x16_bf16(kf[j][s], qf[s], sc[j], 0, 0, 0); }
    asm volatile("" ::: "memory");
    bf16x8 vf[5][2][2];
    const bf16_t* vp = VT + ((size_t)(hk * 64 + i)) * SEQ + 8 * hi;
#pragma unroll
    for (int j = 0; j < 5; ++j) { const int jj = j < jmin ? jmin : j; const int kb = q0 - 128 + 32 * jj;
#pragma unroll
        for (int ks = 0; ks < 2; ++ks)
#pragma unroll
            for (int dt = 0; dt < 2; ++dt) vf[j][ks][dt] = *(const bf16x8*)(vp + (size_t)(32 * dt) * SEQ + kb + 16 * ks); }
    const float NEG = -INFINITY;
    float mx = sink2;
#pragma unroll
    for (int j = 0; j < 5; ++j) {
#pragma unroll
        for (int r = 0; r < 16; ++r) { const int kk = 8 * hi + (r & 7) + 16 * (r >> 3);
            bool ok = j >= jmin;
            if (j == 0) ok = ok && (kk >= i + 1);
            if (j == 4) ok = ok && (kk <= i);
            sc[j][r] = ok ? sc[j][r] : NEG;
            mx = fmaxf(mx, sc[j][r]); } }
    mx = fmaxf(mx, __shfl_xor(mx, 32));
    float l = 0.f;
    f32x16 o[2]; o[0] = (f32x16){}; o[1] = (f32x16){};
#pragma unroll
    for (int j = 0; j < 5; ++j) {
#pragma unroll
        for (int r = 0; r < 16; ++r) { sc[j][r] = __builtin_amdgcn_exp2f(sc[j][r] - mx); l += sc[j][r]; }
        u32x4 pw[2];
        pw[0] = (u32x4){cvt_pk_bf16(sc[j][0], sc[j][1]), cvt_pk_bf16(sc[j][2], sc[j][3]), cvt_pk_bf16(sc[j][4], sc[j][5]), cvt_pk_bf16(sc[j][6], sc[j][7])};
        pw[1] = (u32x4){cvt_pk_bf16(sc[j][8], sc[j][9]), cvt_pk_bf16(sc[j][10], sc[j][11]), cvt_pk_bf16(sc[j][12], sc[j][13]), cvt_pk_bf16(sc[j][14], sc[j][15])};
#pragma unroll
        for (int ks = 0; ks < 2; ++ks)
#pragma unroll
            for (int dt = 0; dt < 2; ++dt) o[dt] = __builtin_amdgcn_mfma_f32_32x32x16_bf16(vf[j][ks][dt], __builtin_bit_cast(bf16x8, pw[ks]), o[dt], 0, 0, 0);
        __builtin_amdgcn_sched_barrier(0);
    }
    l += __shfl_xor(l, 32);
    l += __builtin_amdgcn_exp2f(sink2 - mx);
    const float rl = 1.0f / l;
    bf16_t* op = Oa + (rowbase + q0 + i) * AD + h * 64 + 4 * hi;
#pragma unroll
    for (int dt = 0; dt < 2; ++dt)
#pragma unroll
        for (int rq = 0; rq < 4; ++rq) { u32x2 w; w.x = cvt_pk_bf16(o[dt][4 * rq] * rl, o[dt][4 * rq + 1] * rl); w.y = cvt_pk_bf16(o[dt][4 * rq + 2] * rl, o[dt][4 * rq + 3] * rl);
            *(u32x2*)(op + 32 * dt + 8 * rq) = w; }
}

__device__ __forceinline__ void mixer_phase(const Args& a, int l, int vgw, int NGW, int lane) {
    asm volatile("" : "+v"(lane));
    unsigned char* ws = a.ws;
    const int wpb = NGW / NB;
    const int b = vgw / wpb, lw = vgw % wpb;
    const bf16_t* ar = (const bf16_t*)(ws + WS_BIG) + (size_t)b * ARE;
    const bf16_t* U = ar + AR_U / 2; bf16_t* Dp = (bf16_t*)(ws + WS_DP) + (size_t)b * SEQ * PD;
    for (int it = lw + (((SEQ / 32) * 4 - 1 - lw) / wpb) * wpb; it >= 0; it -= wpb) {
        const int g = it & 3, chunk = it >> 2;
        const int row0 = chunk * 32 + (lane >> 4) * 8, ch = g * 128 + (lane & 15) * 8;
        if (g == 0) pool_item<2>(U, Dp, row0, ch); else if (g == 1) pool_item<4>(U, Dp, row0, ch); else if (g == 2) pool_item<8>(U, Dp, row0, ch); else pool_item<16>(U, Dp, row0, ch);
    }
    const bf16_t* Q = ar + AR_Q / 2; const bf16_t* Kb = ar + AR_K / 2; const bf16_t* VT = ar + AR_VT / 2; bf16_t* Oa = (bf16_t*)(ws + WS_OA) + (size_t)b * SEQ * AD;
    for (int it = lw + ((8 * (SEQ / 32) - 1 - lw) / wpb) * wpb; it >= 0; it -= wpb) {
        const int g = it & 3, qb = (it >> 2) & 255, hk = it >> 10, h = hk * 4 + g;
        const float sink2 = a.sinks[l * 8 + h] * LOG2E;
        attn_item(Q, Kb, VT, Oa, sink2, h, qb * 32, lane);
    }
}

#define XB_TMO      128
#define XB_XCNT(j)  (256  + 64 * (j))
#define XB_XSUB(j)  (1280 + 64 * (j))
#define XB_XGEN(j)  (2304 + 64 * (j))
#define XB_TOP      3328
#define XB_TOPGEN   3392
#define XCD_BAR_WORDS 3456
#define XB_SPIN_CAP (1u << 22)
__device__ __forceinline__ unsigned xb_ld(unsigned* p)              { return __hip_atomic_load(p, __ATOMIC_RELAXED, __HIP_MEMORY_SCOPE_AGENT); }
__device__ __forceinline__ unsigned xb_add(unsigned* p, unsigned v) { return __hip_atomic_fetch_add(p, v, __ATOMIC_RELAXED, __HIP_MEMORY_SCOPE_AGENT); }
__device__ __forceinline__ unsigned xb_xcc_id() { return (unsigned)__builtin_amdgcn_s_getreg((3 << 11) | 20) & 0xFu; }
#define XB_SPIN(cond, bar) do { unsigned _sp = 0; while (cond) { __builtin_amdgcn_s_sleep(1); \
    if ((++_sp & 255u) == 0u) { if (xb_ld(&(bar)[XB_TMO])) break; if (_sp > XB_SPIN_CAP) { atomicAdd(&(bar)[XB_TMO], 1u); break; } } } } while (0)
__device__ __forceinline__ void xcd_barrier_complete(unsigned* bar, unsigned x, unsigned& nloc, unsigned& nx, unsigned& uniform8) {
    const unsigned G = gridDim.x * gridDim.y * gridDim.z;
    unsigned sum, cnt, mine, bad, sp = 0u;
    for (;;) {
        sum = 0u; cnt = 0u; mine = 0u; bad = 0u;
#pragma unroll
        for (unsigned j = 0; j < 16; ++j) { const unsigned c = xb_ld(&bar[XB_XCNT(j)]); sum += c; cnt += (c > 0u) ? 1u : 0u; mine = (j == x) ? c : mine; bad |= (j < 8u) ? (c * 8u != G) : (c != 0u); }
        if (sum == G) break;
        __builtin_amdgcn_s_sleep(1);
        if ((++sp & 255u) == 0u) { if (xb_ld(&bar[XB_TMO])) break; if (sp > XB_SPIN_CAP) { atomicAdd(&bar[XB_TMO], 1u); break; } }
    }
    nloc = mine > 0u ? mine : 1u; nx = cnt > 0u ? cnt : 1u; uniform8 = (sum == G && bad == 0u) ? 1u : 0u;
}
__device__ __forceinline__ void xcd_barrier(unsigned* bar_in, volatile LAS unsigned* st, bool local) {
    asm volatile("s_waitcnt vmcnt(0)" ::: "memory");
    __syncthreads();
    int t0 = threadIdx.x; asm volatile("" : "+v"(t0));
    if (t0 == 0) {
        unsigned* bar = bar_in; asm volatile("" : "+s"(bar));
        const unsigned bx = xb_xcc_id();
        __builtin_amdgcn_s_waitcnt(0);
        unsigned nloc = st[0], nx = st[1];
        if (nloc == 0u) { unsigned u8; xcd_barrier_complete(bar, bx, nloc, nx, u8); st[0] = nloc; st[1] = nx; st[2] = u8; }
        const unsigned old = xb_add(&bar[XB_XSUB(bx)], 1u);
        const unsigned gen = old / nloc;
        if (old + 1u == (gen + 1u) * nloc) {
            if (!local) {
                __builtin_amdgcn_fence(__ATOMIC_RELEASE, "agent");
                asm volatile("s_waitcnt vmcnt(0)" ::: "memory");
                const unsigned og = xb_add(&bar[XB_TOP], 1u);
                const unsigned tg = og / nx;
                if (og + 1u == (tg + 1u) * nx) xb_add(&bar[XB_TOPGEN], 1u);
                else XB_SPIN(xb_ld(&bar[XB_TOPGEN]) == tg, bar);
            }
            __builtin_amdgcn_fence(__ATOMIC_ACQUIRE, "agent");
            xb_add(&bar[XB_XGEN(bx)], 1u);
            asm volatile("s_waitcnt vmcnt(0)" ::: "memory");
        } else {
            XB_SPIN(xb_ld(&bar[XB_XGEN(bx)]) == gen, bar);
            __builtin_amdgcn_fence(__ATOMIC_ACQUIRE, "agent");
            asm volatile("s_waitcnt vmcnt(0)" ::: "memory");
        }
    }
    __syncthreads();
}

#ifndef SKEW_TICKS
#define SKEW_TICKS 0
#endif
constexpr int LDS_BYTES = 131072 + 8192;
__global__ void __launch_bounds__(512, 2) fwd_kernel(Args a) {
    extern __shared__ __attribute__((aligned(16))) unsigned char lds_raw[];
    LAS unsigned char* lds = (LAS unsigned char*)lds_raw;
    cg::grid_group grid = cg::this_grid();
    grid.sync();
    volatile LAS unsigned* ctlw = (volatile LAS unsigned*)(lds + 131072);
    if (threadIdx.x < 16) ctlw[threadIdx.x] = 0u;
    __syncthreads();
    if (threadIdx.x == 0) { const unsigned x = xb_xcc_id(); ctlw[12] = xb_add(&((unsigned*)a.ws)[XB_XCNT(x)], 1u); ctlw[13] = x; }
    const int tid = threadIdx.x, lane = tid & 63, wave = __builtin_amdgcn_readfirstlane(tid >> 6);
    const int G = gridDim.x, NGW = G * 8;
    unsigned char* ws = a.ws;
    float* ss = (float*)(ws + WS_SS);
    bf16_t* XB = (bf16_t*)(ws + WS_XB); bf16_t* BIG = (bf16_t*)(ws + WS_BIG);

    prologue(a, lds, blockIdx.x * 8 + wave, NGW, lane, wave);
    xcd_barrier((unsigned*)a.ws, ctlw + 8, false);
    const bool local = (G == 256) && (__builtin_amdgcn_readfirstlane(ctlw[10]) == 1u);
    const int vc = local ? (int)(__builtin_amdgcn_readfirstlane(ctlw[12]) * 8u + __builtin_amdgcn_readfirstlane(ctlw[13])) : (int)blockIdx.x;
    const int vgw = (G == 256) ? ((vc & 7) * 256 + (vc >> 3) * 8 + wave) : (vc * 8 + wave);
#define GRID_SYNC() xcd_barrier((unsigned*)a.ws, ctlw + 8, local)
#if SKEW_TICKS > 0
    if (local) { const unsigned long long t0 = __builtin_amdgcn_s_memrealtime(); const unsigned long long w = (unsigned long long)(vc & 7) * SKEW_TICKS;
        while (__builtin_amdgcn_s_memrealtime() - t0 < w) __builtin_amdgcn_s_sleep(32); }
#endif

#pragma unroll 1
    for (int l = 0; l < DEPTH; ++l) {
        const unsigned char* wl = ws + WS_W + (size_t)l * LW_BYTES;
        pg8::StaticOrder S;
        constexpr size_t PAD_H = ARENA - (size_t)SEQ * FF * 2, PAD_MB = ARENA - (size_t)SEQ * DM * 2;
#pragma unroll 1
        for (int hf = 0; hf < 2; ++hf) {
            {
                pg8::Gemm g{XB, (const bf16_t*)(wl + LW_GU1), M, NGU, DM, 0, nullptr, nullptr}; S.init(M / 2, NGU, G, vc, 0, 0, hf);
                EpiGU E{BIG, ss};
                pg8::gemm_phase<EpiGU, true>(lds, g, S, E);
            }
            GRID_SYNC();
            {
                pg8::Gemm g{BIG, (const bf16_t*)(wl + LW_D1), M, DM, FF, PAD_H, nullptr, nullptr}; S.init(M / 2, DM, G, vc, 0, 1, hf);
                EpiResid E{XB, nullptr, ss, 0.5f};
                pg8::gemm_phase<EpiResid, true, true>(lds, g, S, E);
            }
            GRID_SYNC();
        }
        {
            pg8::Gemm g{XB, (const bf16_t*)(wl + LW_IN), M, NIN, DM, 0, nullptr, nullptr}; S.init(M, NIN, G, vc);
            EpiWin E{ss, BIG, a.qn + l * 64, a.kn + l * 64, (const float*)(ws + WS_ROPE)};
            pg8::gemm_phase<EpiWin, true>(lds, g, S, E);
        }
        GRID_SYNC();
        mixer_phase(a, l, vgw, NGW, lane);
        GRID_SYNC();
        {
            S.init(M, DM, G, vc, 1);
            pg8::Gemm g{(const bf16_t*)(ws + WS_DP), (const bf16_t*)(wl + LW_PB), M, DM, PD, 0, (const bf16_t*)(ws + WS_OA), (const bf16_t*)(wl + LW_AB)};
            EpiBranch E{BIG};
            pg8::gemm_phase<EpiBranch, true>(lds, g, S, E);
        }
        GRID_SYNC();
        {
            pg8::Gemm g{BIG + AR_U / 2, (const bf16_t*)(wl + LW_OUT), M, DM, DM, PAD_MB, nullptr, nullptr}; S.init(M, DM, G, vc, 0, 1);
            EpiResid E{XB, nullptr, ss, 1.0f};
            pg8::gemm_phase<EpiResid, true>(lds, g, S, E);
        }
        GRID_SYNC();
#pragma unroll 1
        for (int hf = 0; hf < 2; ++hf) {
            {
                pg8::Gemm g{XB, (const bf16_t*)(wl + LW_GU2), M, NGU, DM, 0, nullptr, nullptr}; S.init(M / 2, NGU, G, vc, 0, 0, hf);
                EpiGU E{BIG, ss};
                pg8::gemm_phase<EpiGU, true>(lds, g, S, E);
            }
            GRID_SYNC();
            {
                pg8::Gemm g{BIG, (const bf16_t*)(wl + LW_D2), M, DM, FF, PAD_H, nullptr, nullptr}; S.init(M / 2, DM, G, vc, 0, 1, hf);
                EpiResid E{XB, l < DEPTH - 1 ? nullptr : a.out, l < DEPTH - 1 ? ss : nullptr, 0.5f};
                pg8::gemm_phase<EpiResid, true, true>(lds, g, S, E);
            }
            if (l < DEPTH - 1 || hf == 0) GRID_SYNC();
        }
    }
}

extern "C" void kernel_launch(void* const* d_in, const int* in_sizes, int n_in, void* d_out, int out_size, void* d_ws, size_t ws_size, hipStream_t stream) {
    static int grid = 0;
    if (grid == 0) {
        if (n_in != 17 || in_sizes[0] != M * DM || out_size != M * DM || ws_size < WS_END) { fprintf(stderr, "kernel_launch: unexpected shapes (n_in %d, in0 %d, out %d, ws %zu)\n", n_in, n_in > 0 ? in_sizes[0] : -1, out_size, ws_size); grid = -1; return; }
        int dev = 0, cus = 0, per_cu = 0;
        if (hipGetDevice(&dev) != hipSuccess || hipDeviceGetAttribute(&cus, hipDeviceAttributeMultiprocessorCount, dev) != hipSuccess) { grid = -1; return; }
        if (hipFuncSetAttribute((const void*)fwd_kernel, hipFuncAttributeMaxDynamicSharedMemorySize, LDS_BYTES) != hipSuccess) { fprintf(stderr, "kernel_launch: hipFuncSetAttribute failed\n"); grid = -1; return; }
        if (hipOccupancyMaxActiveBlocksPerMultiprocessor(&per_cu, (const void*)fwd_kernel, 512, LDS_BYTES) != hipSuccess || per_cu < 1) per_cu = 1;
        (void)hipGetLastError();
        grid = cus * per_cu;
    }
    if (grid < 0) return;
    Args a{};
    a.x = (const float*)d_in[0]; a.ln1 = (const float*)d_in[1]; a.wgu1 = (const float*)d_in[2]; a.wd1 = (const float*)d_in[3]; a.lnm = (const float*)d_in[4];
    a.win = (const float*)d_in[5]; a.poolw = (const float*)d_in[6]; a.pscale = (const float*)d_in[7]; a.wpb = (const float*)d_in[8]; a.qn = (const float*)d_in[9];
    a.kn = (const float*)d_in[10]; a.sinks = (const float*)d_in[11]; a.wab = (const float*)d_in[12]; a.wout = (const float*)d_in[13]; a.ln2 = (const float*)d_in[14];
    a.wgu2 = (const float*)d_in[15]; a.wd2 = (const float*)d_in[16];
    a.out = (float*)d_out; a.ws = (unsigned char*)d_ws;
    void* args[] = {&a};
    if (hipMemsetAsync(d_ws, 0, 16384, stream) != hipSuccess) { fprintf(stderr, "kernel_launch: hipMemsetAsync failed\n"); return; }
    const hipError_t e = hipLaunchCooperativeKernel((const void*)fwd_kernel, dim3(grid), dim3(512), args, LDS_BYTES, stream);
    if (e != hipSuccess) fprintf(stderr, "kernel_launch: cooperative launch failed: %s (grid %d)\n", hipGetErrorString(e), grid);
}
```
